# Optimizing an MI355X kernel written in HIP

```python
import jax, jax.numpy as jnp
from jax import lax
import numpy as np

D_MODEL = 1024
BATCH = 2
SEQ = 8192
DEPTH = 2
DEC_BATCH = 128
DEC_SEQ = 1
PAST_LEN = 8192
PAGE_SIZE = 128

D_CONV = D_MODEL // 2
CONV_W = 3
HEAD_DIM = 64
N_HEADS = (D_MODEL // 2) // HEAD_DIM
N_KV_HEADS = 2
GROUP = N_HEADS // N_KV_HEADS
WINDOW = 128
BLK = WINDOW
D_ATTN = N_HEADS * HEAD_DIM
D_KV = N_KV_HEADS * HEAD_DIM
MIX = D_CONV + D_ATTN
IN_COLS = 3 * D_CONV + D_ATTN + 2 * D_KV
MEM_LEN = 256
MEM_HEADS = 4
MEM_HEAD_DIM = D_MODEL // MEM_HEADS
MEM_INNER = MEM_HEADS * MEM_HEAD_DIM
D_FF = 2816
ALPHA = (2.0 * DEPTH) ** 0.25
BETA = (8.0 * DEPTH) ** -0.25
LN_EPS = 1e-5

kernel_name = 'hymba_conv_swa_sink_macaron_deepnorm_step'


def _layer_norm(x, g, b):
    xf = x.astype(jnp.float32)
    mu = xf.mean(-1, keepdims=True)
    var = jnp.square(xf - mu).mean(-1, keepdims=True)
    y = (xf - mu) * lax.rsqrt(var + LN_EPS) * g.astype(jnp.float32) + b.astype(jnp.float32)
    return y.astype(x.dtype)


def _deepnorm(x, sub, g, b):
    return _layer_norm(ALPHA * x + sub, g, b)


def _swiglu_half(x, w_gu, w_down):
    g, u = jnp.split(x @ w_gu, 2, axis=-1)
    return 0.5 * ((jax.nn.silu(g) * u) @ w_down)


def _split_in(p):
    cuts = [D_CONV, 2 * D_CONV, 3 * D_CONV, 3 * D_CONV + D_ATTN, 3 * D_CONV + D_ATTN + D_KV]
    return jnp.split(p, cuts, axis=-1)


def _dwconv(u_pad, w):
    T = u_pad.shape[1] - (CONV_W - 1)
    y = w[0] * u_pad[:, 0:T]
    for tap in range(1, CONV_W):
        y = y + w[tap] * u_pad[:, tap:tap + T]
    return y


def _sink_attend(q, k, v, mask, sinks):
    s = jnp.einsum('...qkgd,...ckd->...kgqc', q.astype(jnp.float32), k.astype(jnp.float32)) * (HEAD_DIM ** -0.5)
    s = jnp.where(mask, s, -jnp.inf)
    sk = sinks.astype(jnp.float32).reshape(N_KV_HEADS, GROUP, 1, 1)
    m = jnp.maximum(s.max(-1, keepdims=True), sk)
    p = jnp.exp(s - m)
    denom = p.sum(-1, keepdims=True) + jnp.exp(sk - m)
    o = jnp.einsum('...kgqc,...ckd->...qkgd', p / denom, v.astype(jnp.float32))
    return o.astype(v.dtype)


def _swa_prompt(q, k, v, sinks):
    Bn, S = q.shape[0], q.shape[1]
    nb = S // BLK
    qb = q.reshape(Bn, nb, BLK, N_KV_HEADS, GROUP, HEAD_DIM)
    kb = k.reshape(Bn, nb, BLK, N_KV_HEADS, HEAD_DIM)
    vb = v.reshape(Bn, nb, BLK, N_KV_HEADS, HEAD_DIM)
    pad = jnp.zeros_like(kb[:, :1])
    kk = jnp.concatenate([jnp.concatenate([pad, kb[:, :-1]], axis=1), kb], axis=2)
    vv = jnp.concatenate([jnp.concatenate([pad, vb[:, :-1]], axis=1), vb], axis=2)
    a = jnp.arange(BLK)[None, :, None]
    c = jnp.arange(2 * BLK)[None, None, :]
    blk = jnp.arange(nb)[:, None, None]
    rel = BLK + a - c
    mask = (rel >= 0) & (rel <= WINDOW) & ((blk - 1) * BLK + c >= 0)
    o = _sink_attend(qb, kk, vv, mask[None, :, None, None], sinks)
    return o.reshape(Bn, S, D_ATTN)


def _swa_sample(q, k_new, v_new, k_buf, v_buf, sinks):
    Bn, T = q.shape[0], q.shape[1]
    kk = jnp.concatenate([k_buf, k_new], axis=1)
    vv = jnp.concatenate([v_buf, v_new], axis=1)
    a = jnp.arange(T)[:, None]
    c = jnp.arange(WINDOW + T)[None, :]
    rel = WINDOW + a - c
    mask = (rel >= 0) & (rel <= WINDOW)
    o = _sink_attend(q.reshape(Bn, T, N_KV_HEADS, GROUP, HEAD_DIM), kk, vv, mask, sinks)
    return o.reshape(Bn, T, D_ATTN), kk[:, -WINDOW:], vv[:, -WINDOW:]


def _token_mix(x, w_in, conv_w, w_out, sinks, conv_prev, k_buf, v_buf):
    Bn, T = x.shape[0], x.shape[1]
    bg, cg, hc, q, k, v = _split_in(x @ w_in)
    u = cg * hc
    u_pad = jnp.concatenate([conv_prev, u], axis=1)
    z_conv = bg * _dwconv(u_pad, conv_w)
    new_conv = u_pad[:, -(CONV_W - 1):]
    k4 = k.reshape(Bn, T, N_KV_HEADS, HEAD_DIM)
    v4 = v.reshape(Bn, T, N_KV_HEADS, HEAD_DIM)
    if k_buf is None:
        z_attn = _swa_prompt(q, k4, v4, sinks)
        new_k, new_v = k4[:, -WINDOW:], v4[:, -WINDOW:]
    else:
        z_attn, new_k, new_v = _swa_sample(q, k4, v4, k_buf, v_buf, sinks)
    out = jnp.concatenate([z_conv, z_attn], axis=-1) @ w_out
    return out, new_conv, new_k, new_v


def _mem_kv(mem, w_mk, w_mv):
    Bn, M = mem.shape[0], mem.shape[1]
    mk = (mem @ w_mk).reshape(Bn, M, MEM_HEADS, MEM_HEAD_DIM)
    mv = (mem @ w_mv).reshape(Bn, M, MEM_HEADS, MEM_HEAD_DIM)
    return mk, mv


def _cross_attend(x, mk, mv, w_cq, w_co):
    Bn, T = x.shape[0], x.shape[1]
    q = (x @ w_cq).reshape(Bn, T, MEM_HEADS, MEM_HEAD_DIM)
    s = jnp.einsum('bthd,bmhd->bhtm', q.astype(jnp.float32), mk.astype(jnp.float32)) * (MEM_HEAD_DIM ** -0.5)
    p = jax.nn.softmax(s, axis=-1)
    o = jnp.einsum('bhtm,bmhd->bthd', p, mv.astype(jnp.float32)).astype(x.dtype)
    return o.reshape(Bn, T, MEM_INNER) @ w_co


def setup_inputs(seed: int = 0) -> dict:
    key = jax.random.key(seed)
    ks = jax.random.split(key, 24)
    f32 = jnp.float32
    nrm = lambda k, shape, scale: jax.random.normal(k, shape, f32) * scale
    w_in = nrm(ks[10], (DEPTH, D_MODEL, IN_COLS), D_MODEL ** -0.5)
    w_in = w_in.at[..., -D_KV:].multiply(BETA)
    return {
        'x_prompt': nrm(ks[0], (BATCH, SEQ, D_MODEL), 1.0),
        'x_sample': nrm(ks[1], (DEC_BATCH, DEC_SEQ, D_MODEL), 1.0),
        'mem_prompt': nrm(ks[2], (BATCH, MEM_LEN, D_MODEL), 1.0),
        'cache_win_k': nrm(ks[3], (DEPTH, DEC_BATCH, WINDOW, N_KV_HEADS, HEAD_DIM), 1.0),
        'cache_win_v': nrm(ks[4], (DEPTH, DEC_BATCH, WINDOW, N_KV_HEADS, HEAD_DIM), BETA),
        'state_conv': nrm(ks[5], (DEPTH, DEC_BATCH, CONV_W - 1, D_CONV), 1.0),
        'cache_mem_k': nrm(ks[6], (DEPTH, DEC_BATCH, MEM_LEN, MEM_HEADS, MEM_HEAD_DIM), 1.0),
        'cache_mem_v': nrm(ks[7], (DEPTH, DEC_BATCH, MEM_LEN, MEM_HEADS, MEM_HEAD_DIM), BETA),
        'ln_g': 1.0 + nrm(ks[8], (DEPTH, 4, D_MODEL), 0.02),
        'ln_b': nrm(ks[9], (DEPTH, 4, D_MODEL), 0.02),
        'ffn1_w_gu': nrm(ks[11], (DEPTH, D_MODEL, 2 * D_FF), D_MODEL ** -0.5),
        'ffn1_w_down': nrm(ks[12], (DEPTH, D_FF, D_MODEL), BETA * D_FF ** -0.5),
        'w_in': w_in,
        'conv_w': nrm(ks[13], (DEPTH, CONV_W, D_CONV), CONV_W ** -0.5),
        'attn_sinks': nrm(ks[14], (DEPTH, N_HEADS), 0.5),
        'w_out': nrm(ks[15], (DEPTH, MIX, D_MODEL), BETA * MIX ** -0.5),
        'w_cq': nrm(ks[16], (DEPTH, D_MODEL, MEM_INNER), D_MODEL ** -0.5),
        'w_mk': nrm(ks[17], (DEPTH, D_MODEL, MEM_INNER), D_MODEL ** -0.5),
        'w_mv': nrm(ks[18], (DEPTH, D_MODEL, MEM_INNER), BETA * D_MODEL ** -0.5),
        'w_co': nrm(ks[19], (DEPTH, MEM_INNER, D_MODEL), BETA * MEM_INNER ** -0.5),
        'ffn2_w_gu': nrm(ks[20], (DEPTH, D_MODEL, 2 * D_FF), D_MODEL ** -0.5),
        'ffn2_w_down': nrm(ks[21], (DEPTH, D_FF, D_MODEL), BETA * D_FF ** -0.5),
    }


def reference(x_prompt, x_sample, mem_prompt, cache_win_k, cache_win_v, state_conv, cache_mem_k, cache_mem_v,
              ln_g, ln_b, ffn1_w_gu, ffn1_w_down, w_in, conv_w, attn_sinks, w_out,
              w_cq, w_mk, w_mv, w_co, ffn2_w_gu, ffn2_w_down):
    yp, ys = x_prompt, x_sample
    wkp, wvp, cvp, mkp, mvp = [], [], [], [], []
    wks, wvs, cvs = [], [], []
    for l in range(DEPTH):
        yp = _deepnorm(yp, _swiglu_half(yp, ffn1_w_gu[l], ffn1_w_down[l]), ln_g[l, 0], ln_b[l, 0])
        ys = _deepnorm(ys, _swiglu_half(ys, ffn1_w_gu[l], ffn1_w_down[l]), ln_g[l, 0], ln_b[l, 0])
        conv0 = jnp.zeros((yp.shape[0], CONV_W - 1, D_CONV), yp.dtype)
        mix_p, cst_p, kp, vp = _token_mix(yp, w_in[l], conv_w[l], w_out[l], attn_sinks[l], conv0, None, None)
        mix_s, cst_s, ksn, vsn = _token_mix(ys, w_in[l], conv_w[l], w_out[l], attn_sinks[l],
                                            state_conv[l], cache_win_k[l], cache_win_v[l])
        yp = _deepnorm(yp, mix_p, ln_g[l, 1], ln_b[l, 1])
        ys = _deepnorm(ys, mix_s, ln_g[l, 1], ln_b[l, 1])
        wkp.append(kp); wvp.append(vp); cvp.append(cst_p)
        wks.append(ksn); wvs.append(vsn); cvs.append(cst_s)
        mk, mv = _mem_kv(mem_prompt, w_mk[l], w_mv[l])
        mkp.append(mk); mvp.append(mv)
        yp = _deepnorm(yp, _cross_attend(yp, mk, mv, w_cq[l], w_co[l]), ln_g[l, 2], ln_b[l, 2])
        ys = _deepnorm(ys, _cross_attend(ys, cache_mem_k[l], cache_mem_v[l], w_cq[l], w_co[l]), ln_g[l, 2], ln_b[l, 2])
        yp = _deepnorm(yp, _swiglu_half(yp, ffn2_w_gu[l], ffn2_w_down[l]), ln_g[l, 3], ln_b[l, 3])
        ys = _deepnorm(ys, _swiglu_half(ys, ffn2_w_gu[l], ffn2_w_down[l]), ln_g[l, 3], ln_b[l, 3])
    new_win_k_prompt = jnp.stack(wkp)
    new_win_v_prompt = jnp.stack(wvp)
    new_conv_prompt = jnp.stack(cvp)
    new_mem_k_prompt = jnp.stack(mkp)
    new_mem_v_prompt = jnp.stack(mvp)
    new_win_k_sample = jnp.stack(wks)
    new_win_v_sample = jnp.stack(wvs)
    new_conv_sample = jnp.stack(cvs)
    return (yp, ys, new_win_k_prompt, new_win_v_prompt, new_conv_prompt, new_mem_k_prompt, new_mem_v_prompt,
            new_win_k_sample, new_win_v_sample, new_conv_sample)
```

```cpp
#include <hip/hip_runtime.h>
#include <hip/hip_cooperative_groups.h>
#include <cstdio>
namespace cg = cooperative_groups;

#define LAS __attribute__((address_space(3)))
typedef unsigned short bf16_t;
typedef short bf16x8 __attribute__((ext_vector_type(8)));
typedef short s16x4 __attribute__((ext_vector_type(4)));
typedef float f32x4 __attribute__((ext_vector_type(4)));
typedef float f32x16 __attribute__((ext_vector_type(16)));
typedef unsigned u32x4 __attribute__((ext_vector_type(4)));
typedef unsigned u32x2 __attribute__((ext_vector_type(2)));

constexpr int TP = 16384, TS = 128, MT = TP + TS, DM = 1024, DFF = 2816, INC = 2304, SEQ = 8192;
constexpr float ALPHA = 1.41421356237309515f;
constexpr float LN_EPS = 1e-5f;
constexpr int LDS_BYTES = 131072;

constexpr size_t OUT_YP = 0, OUT_YS = 16777216, OUT_WKP = OUT_YS + 131072, OUT_WVP = OUT_WKP + 65536, OUT_CVP = OUT_WVP + 65536,
                 OUT_MKP = OUT_CVP + 4096, OUT_MVP = OUT_MKP + 1048576, OUT_WKS = OUT_MVP + 1048576, OUT_WVS = OUT_WKS + 4194304, OUT_CVS = OUT_WVS + 4194304;

constexpr size_t SZ_GU = (size_t)5632 * 1024 * 2, SZ_DN = (size_t)1024 * 2816 * 2, SZ_IN = (size_t)2304 * 1024 * 2, SZ_SQ = (size_t)1024 * 1024 * 2;
constexpr size_t WL_GU1 = 0, WL_D1 = WL_GU1 + SZ_GU, WL_IN = WL_D1 + SZ_DN, WL_OUT = WL_IN + SZ_IN, WL_CQ = WL_OUT + SZ_SQ, WL_CO = WL_CQ + SZ_SQ,
                 WL_GU2 = WL_CO + SZ_SQ, WL_D2 = WL_GU2 + SZ_GU, WL_SIZE = WL_D2 + SZ_DN;
constexpr size_t WS_W = 0, WS_MKVW = WS_W + 2 * WL_SIZE, WS_MEMB = WS_MKVW + (size_t)4096 * 1024 * 2, WS_MK = WS_MEMB + (size_t)512 * 1024 * 2,
                 WS_VT = WS_MK + (size_t)2 * 512 * 1024 * 2, WS_Y = WS_VT + (size_t)2 * 512 * 1024 * 2, WS_Z = WS_Y + (size_t)MT * 1024 * 2,
                 WS_R1 = WS_Z + (size_t)MT * 1024 * 4, WS_R2 = WS_R1 + (size_t)MT * 2816 * 2, WS_END = WS_R2 + (size_t)MT * 1024 * 2;

struct Params { const float* in[22]; float* out; unsigned char* ws; };

__device__ __forceinline__ unsigned cvt_pk_bf16(float lo, float hi) { unsigned r; asm("v_cvt_pk_bf16_f32 %0, %1, %2" : "=v"(r) : "v"(lo), "v"(hi)); return r; }
__device__ __forceinline__ float bflo(unsigned w) { return __uint_as_float(w << 16); }
__device__ __forceinline__ float bfhi(unsigned w) { return __uint_as_float(w & 0xffff0000u); }
__device__ __forceinline__ float bf2f(bf16_t b) { return __uint_as_float(((unsigned)b) << 16); }
__device__ __forceinline__ bf16_t f2bf(float f) { return (bf16_t)(cvt_pk_bf16(f, 0.f) & 0xffffu); }

__device__ __forceinline__ int otid() { int t = threadIdx.x; asm volatile("" : "+v"(t)); return t; }
__device__ __forceinline__ int obid() { int t = blockIdx.x; asm volatile("" : "+s"(t)); return t; }
__device__ __forceinline__ int ogrid() { int t = gridDim.x; asm volatile("" : "+s"(t)); return t; }
__device__ __forceinline__ float wave_sum(float v) {
#pragma unroll
    for (int o = 32; o >= 1; o >>= 1) v += __shfl_xor(v, o);
    return v;
}
__device__ __forceinline__ float wave_max(float v) {
#pragma unroll
    for (int o = 32; o >= 1; o >>= 1) v = fmaxf(v, __shfl_xor(v, o));
    return v;
}

namespace pg8 {
constexpr int BM = 256, BK = 64, HALF = 128, HTB = HALF * BK * 2, STAGE_BYTES = 8 * HTB, NXCD = 8, WGM = 8;
__host__ __device__ __forceinline__ int lds_byte(int r, int c) { const int st = (r >> 4) * 2 + (c >> 5), rr = r & 15, cc = c & 31, ob = rr * 64 + cc * 2; return st * 1024 + (ob ^ (((ob >> 9) & 1) << 5)); }
__host__ __device__ __forceinline__ void stage_rc(int b, int& R, int& C) { const int st = b / 1024, sb = b % 1024, swz = sb ^ (((sb >> 9) & 1) << 5); R = (st >> 1) * 16 + swz / 64; C = (st & 1) * 32 + (swz % 64) / 2; }
__host__ __device__ __forceinline__ int perm32(int rho) { const int n = rho >> 4, i = rho & 15; return 8 * (i >> 2) + 4 * n + (i & 3); }
struct Unit { int pm, pn; };
struct Gemm { const bf16_t* A; const bf16_t* Bt; int M, N, K; };
struct StaticOrder {
    int nM, nN, nwg, G, c;
    __device__ void init(int M, int N, int G_, int c_) { nM = M / BM; nN = N / BM; nwg = nM * nN; G = G_; c = c_; }
    __device__ bool next(int i, Unit& u) const {
        const long L = (long)i * G + c; if (L >= nwg) return false;
        int wgid = (int)L; { const int q = nwg / NXCD, r = nwg % NXCD, xcd = wgid % NXCD, off = wgid / NXCD; wgid = (xcd < r ? xcd * (q + 1) : r * (q + 1) + (xcd - r) * q) + off; }
        const int nig = WGM * nN, gid = wgid / nig, fm = gid * WGM, gsz = (nM - fm) < WGM ? (nM - fm) : WGM;
        u.pm = fm + ((wgid % nig) % gsz); u.pn = (wgid % nig) / gsz; return true;
    }
};

template <class Epi>
__device__ __forceinline__ void gemm_phase(LAS unsigned char* lds, const Gemm g, const StaticOrder& S, const Epi& E) {
    const int tid = otid(), wid = __builtin_amdgcn_readfirstlane(tid >> 6), lane = tid & 63, wr = wid >> 2, wc = wid & 3, fr = lane & 15, fq = lane >> 4;
    const int K = g.K, nt = K / BK;
    unsigned voffA[2], voffB[2];
#pragma unroll
    for (int i = 0; i < 2; ++i) { int R, C; stage_rc(tid * 16 + i * 8192, R, C); const int Rb = Epi::PERM ? ((R & ~31) + perm32(R & 31)) : R;
        voffA[i] = (unsigned)(R * K + C) * 2u; voffB[i] = (unsigned)(Rb * K + C) * 2u; }
    const size_t kstep = (size_t)(BK * 2);
    const size_t hstep = (size_t)HALF * K * 2;
    const size_t tstep = 2 * hstep;
    const unsigned ldsw = (unsigned)wid * 1024u;
    const int aoff = lds_byte(wr * 64 + fr, fq * 8), boff = lds_byte(wc * 32 + fr, fq * 8);
#define PG8_SA(b, h) (((b) * 2 + (h)) * HTB)
#define PG8_SB(b, h) ((4 + (b) * 2 + (h)) * HTB)
#define PG8_STAGE(bufoff, gbase, voff) do { _Pragma("unroll") for (int _i = 0; _i < 2; ++_i) \
        __builtin_amdgcn_global_load_lds((const unsigned*)((const char*)(gbase) + (voff)[_i]), (LAS unsigned*)(lds + (bufoff) + ldsw + _i * 8192), 16, 0, 0); } while (0)
#define PG8_LDA(dst, b, h) do { _Pragma("unroll") for (int m = 0; m < 4; ++m) _Pragma("unroll") for (int k = 0; k < 2; ++k) dst[m][k] = *(const LAS bf16x8*)(lds + PG8_SA(b, h) + aoff + m * 2048 + k * 1024); } while (0)
#define PG8_LDB(dst, b, h) do { _Pragma("unroll") for (int n = 0; n < 2; ++n) _Pragma("unroll") for (int k = 0; k < 2; ++k) dst[n][k] = *(const LAS bf16x8*)(lds + PG8_SB(b, h) + boff + n * 2048 + k * 1024); } while (0)
#define PG8_MMA(ai, bj, At, Bt) do { __builtin_amdgcn_s_setprio(1); _Pragma("unroll") for (int m = 0; m < 4; ++m) _Pragma("unroll") for (int n = 0; n < 2; ++n) _Pragma("unroll") for (int k = 0; k < 2; ++k) \
        acc[ai][bj][m][n] = __builtin_amdgcn_mfma_f32_16x16x32_bf16(Bt[n][k], At[m][k], acc[ai][bj][m][n], 0, 0, 0); __builtin_amdgcn_s_setprio(0); } while (0)
#define PG8_WAIT_V(n) asm volatile("s_waitcnt vmcnt(" #n ")" ::: "memory")
#define PG8_WAIT_L(n) asm volatile("s_waitcnt lgkmcnt(" #n ")" ::: "memory")
#define PG8_BAR __builtin_amdgcn_s_barrier()
#define PG8_SCHED __builtin_amdgcn_sched_barrier(0)
    Unit cur, nxt; int ui = 0;
    if (!S.next(0, cur)) return;
    f32x4 acc[2][2][4][2];
#pragma unroll
    for (int a = 0; a < 2; ++a)
#pragma unroll
        for (int b = 0; b < 2; ++b)
#pragma unroll
            for (int m = 0; m < 4; ++m)
#pragma unroll
                for (int n = 0; n < 2; ++n) acc[a][b][m][n] = (f32x4){0.f, 0.f, 0.f, 0.f};
    bf16x8 At[4][2], B0[2][2], B1[2][2];
    const char* cA = (const char*)g.A + (size_t)cur.pm * tstep; const char* cB = (const char*)g.Bt + (size_t)cur.pn * tstep;
    PG8_STAGE(PG8_SB(0, 0), cB, voffB); PG8_STAGE(PG8_SA(0, 0), cA, voffA); PG8_STAGE(PG8_SB(0, 1), cB + hstep, voffB); PG8_STAGE(PG8_SA(0, 1), cA + hstep, voffA);
    if (wr == 1) PG8_BAR;
    PG8_WAIT_V(4); PG8_BAR;
    PG8_STAGE(PG8_SB(1, 0), cB + kstep, voffB); PG8_STAGE(PG8_SA(1, 0), cA + kstep, voffA); PG8_STAGE(PG8_SB(1, 1), cB + hstep + kstep, voffB);
    PG8_WAIT_V(6); PG8_BAR;
    for (;;) {
        const bool has_next = S.next(ui + 1, nxt);
        const char* nA = has_next ? (const char*)g.A + (size_t)nxt.pm * tstep : cA; const char* nB = has_next ? (const char*)g.Bt + (size_t)nxt.pn * tstep : cB;
        for (int t = 0; t < nt; t += 2) {
            const bool last = (t == nt - 2);
            const char* a1 = cA + (size_t)(t + 1) * kstep;
            const char* a2 = last ? nA : cA + (size_t)(t + 2) * kstep; const char* b2 = last ? nB : cB + (size_t)(t + 2) * kstep;
            const char* a3 = a2 + kstep; const char* b3 = b2 + kstep;
            PG8_LDB(B0, 0, 0); PG8_SCHED; PG8_LDA(At, 0, 0); PG8_STAGE(PG8_SA(1, 1), a1 + hstep, voffA);
            PG8_WAIT_L(8); PG8_BAR; PG8_WAIT_L(0); PG8_MMA(0, 0, At, B0); PG8_BAR; PG8_SCHED;
            PG8_LDB(B1, 0, 1); PG8_STAGE(PG8_SB(0, 0), b2, voffB);
            PG8_BAR; PG8_WAIT_L(0); PG8_MMA(0, 1, At, B1); PG8_BAR;
            PG8_LDA(At, 0, 1); PG8_STAGE(PG8_SA(0, 0), a2, voffA);
            PG8_BAR; PG8_WAIT_L(0); PG8_MMA(1, 0, At, B0); PG8_BAR; PG8_SCHED;
            PG8_STAGE(PG8_SB(0, 1), b2 + hstep, voffB);
            PG8_WAIT_V(6); PG8_BAR; PG8_MMA(1, 1, At, B1); PG8_BAR;
            PG8_LDB(B0, 1, 0); PG8_SCHED; PG8_LDA(At, 1, 0); PG8_STAGE(PG8_SA(0, 1), a2 + hstep, voffA);
            PG8_WAIT_L(8); PG8_BAR; PG8_WAIT_L(0); PG8_MMA(0, 0, At, B0); PG8_BAR; PG8_SCHED;
            PG8_LDB(B1, 1, 1); PG8_STAGE(PG8_SB(1, 0), b3, voffB);
            PG8_BAR; PG8_WAIT_L(0); PG8_MMA(0, 1, At, B1); PG8_BAR;
            PG8_LDA(At, 1, 1); PG8_STAGE(PG8_SA(1, 0), a3, voffA);
            PG8_BAR; PG8_WAIT_L(0); PG8_MMA(1, 0, At, B0); PG8_BAR; PG8_SCHED;
            PG8_STAGE(PG8_SB(1, 1), b3 + hstep, voffB);
            PG8_WAIT_V(6); PG8_BAR; PG8_MMA(1, 1, At, B1); PG8_BAR;
        }
        E(acc, cur, wr, wc, fr, fq);
        if (!has_next) break;
#pragma unroll
        for (int a = 0; a < 2; ++a)
#pragma unroll
            for (int b = 0; b < 2; ++b)
#pragma unroll
                for (int m = 0; m < 4; ++m)
#pragma unroll
                    for (int n = 0; n < 2; ++n) acc[a][b][m][n] = (f32x4){0.f, 0.f, 0.f, 0.f};
        cur = nxt; cA = nA; cB = nB; ++ui;
    }
    PG8_WAIT_V(0);
    if (wr == 0) PG8_BAR;
    PG8_BAR;
#undef PG8_SA
#undef PG8_SB
#undef PG8_STAGE
#undef PG8_LDA
#undef PG8_LDB
#undef PG8_MMA
#undef PG8_WAIT_V
#undef PG8_WAIT_L
#undef PG8_BAR
#undef PG8_SCHED
}
}
using pg8::Unit;

__device__ __forceinline__ float silu_mul(float g, float u) { return g * u * __builtin_amdgcn_rcpf(1.0f + __expf(-g)); }

struct EpiSwiglu {
    static constexpr bool PERM = true;
    bf16_t* H;
    __device__ __forceinline__ void operator()(const f32x4 (&acc)[2][2][4][2], const Unit& u, int wr, int wc, int fr, int fq) const {
        const int row0 = u.pm * 256 + wr * 64 + fr, f0 = u.pn * 128 + wc * 32 + 8 * fq;
#pragma unroll
        for (int ai = 0; ai < 2; ++ai)
#pragma unroll
            for (int m = 0; m < 4; ++m) {
                const f32x4 g0 = acc[ai][0][m][0], g1 = acc[ai][0][m][1], u0 = acc[ai][1][m][0], u1 = acc[ai][1][m][1];
                u32x4 w;
                w.x = cvt_pk_bf16(silu_mul(g0[0], u0[0]), silu_mul(g0[1], u0[1])); w.y = cvt_pk_bf16(silu_mul(g0[2], u0[2]), silu_mul(g0[3], u0[3]));
                w.z = cvt_pk_bf16(silu_mul(g1[0], u1[0]), silu_mul(g1[1], u1[1])); w.w = cvt_pk_bf16(silu_mul(g1[2], u1[2]), silu_mul(g1[3], u1[3]));
                *(u32x4*)(H + (size_t)(row0 + ai * 128 + m * 16) * DFF + f0) = w;
            }
    }
};
struct EpiBf16 {
    static constexpr bool PERM = true;
    bf16_t* O; int ldc;
    __device__ __forceinline__ void operator()(const f32x4 (&acc)[2][2][4][2], const Unit& u, int wr, int wc, int fr, int fq) const {
        const int row0 = u.pm * 256 + wr * 64 + fr, col0 = u.pn * 256 + wc * 32 + 8 * fq;
#pragma unroll
        for (int ai = 0; ai < 2; ++ai)
#pragma unroll
            for (int m = 0; m < 4; ++m) { bf16_t* rowp = O + (size_t)(row0 + ai * 128 + m * 16) * ldc + col0;
#pragma unroll
                for (int bj = 0; bj < 2; ++bj) { const f32x4 v0 = acc[ai][bj][m][0], v1 = acc[ai][bj][m][1];
                    u32x4 w; w.x = cvt_pk_bf16(v0[0], v0[1]); w.y = cvt_pk_bf16(v0[2], v0[3]); w.z = cvt_pk_bf16(v1[0], v1[1]); w.w = cvt_pk_bf16(v1[2], v1[3]);
                    *(u32x4*)(rowp + bj * 128) = w; } }
    }
};
struct EpiRes {
    static constexpr bool PERM = false;
    const bf16_t* Y; float* Z; float scale;
    __device__ __forceinline__ void operator()(const f32x4 (&acc)[2][2][4][2], const Unit& u, int wr, int wc, int fr, int fq) const {
        const int row0 = u.pm * 256 + wr * 64 + fr, col0 = u.pn * 256 + wc * 32 + 4 * fq;
#pragma unroll
        for (int ai = 0; ai < 2; ++ai)
#pragma unroll
            for (int m = 0; m < 4; ++m) { const size_t off = (size_t)(row0 + ai * 128 + m * 16) * 1024 + col0;
#pragma unroll
                for (int bj = 0; bj < 2; ++bj)
#pragma unroll
                    for (int n = 0; n < 2; ++n) { const size_t o = off + bj * 128 + n * 16; const u32x2 yv = *(const u32x2*)(Y + o); const f32x4 a = acc[ai][bj][m][n];
                        f32x4 z; z[0] = ALPHA * bflo(yv.x) + scale * a[0]; z[1] = ALPHA * bfhi(yv.x) + scale * a[1]; z[2] = ALPHA * bflo(yv.y) + scale * a[2]; z[3] = ALPHA * bfhi(yv.y) + scale * a[3];
                        *(f32x4*)(Z + o) = z; } }
    }
};
struct EpiMemKV {
    static constexpr bool PERM = false;
    float* out; bf16_t* MK; bf16_t* VT;
    __device__ __forceinline__ void operator()(const f32x4 (&acc)[2][2][4][2], const Unit& u, int wr, int wc, int fr, int fq) const {
        const int which = u.pn >> 2, l = which >> 1, isv = which & 1, h = u.pn & 3;
        float* ob = out + (isv ? OUT_MVP : OUT_MKP) + (size_t)l * 524288;
#pragma unroll
        for (int ai = 0; ai < 2; ++ai)
#pragma unroll
            for (int m = 0; m < 4; ++m) { const int row = u.pm * 256 + ai * 128 + wr * 64 + m * 16 + fr;
#pragma unroll
                for (int bj = 0; bj < 2; ++bj)
#pragma unroll
                    for (int n = 0; n < 2; ++n) { const int dim = bj * 128 + wc * 32 + n * 16 + 4 * fq; const f32x4 a = acc[ai][bj][m][n];
                        *(f32x4*)(ob + (size_t)row * 1024 + h * 256 + dim) = a;
                        if (!isv) { u32x2 w; w.x = cvt_pk_bf16(a[0], a[1]); w.y = cvt_pk_bf16(a[2], a[3]); *(u32x2*)(MK + (size_t)l * 524288 + (size_t)row * 1024 + h * 256 + dim) = w; }
                        else { bf16_t* vt = VT + ((size_t)((l * 2 + (row >> 8)) * 4 + h)) * 65536 + (size_t)dim * 256 + (row & 255);
                            vt[0] = f2bf(a[0]); vt[256] = f2bf(a[1]); vt[512] = f2bf(a[2]); vt[768] = f2bf(a[3]); } } }
    }
};

template <int MODE>
__device__ __forceinline__ void sample_gemm(LAS unsigned char* lds, const bf16_t* A, int K, const bf16_t* Bt, int N, bf16_t* O, int ldc, const bf16_t* Y, float* Z, float scale) {
    const int tid = otid(), wid = tid >> 6, lane = tid & 63;
    const int nitems = 8 * (MODE == 1 ? DFF / 16 : N / 32);
    const int kw = K >> 3, nks = kw >> 5, k0 = wid * kw;
    LAS f32x4* red = (LAS f32x4*)lds;
    for (int it = obid(); it < nitems; it += ogrid()) {
        const int rg = it & 7, cgp = it >> 3, row0 = rg * 16;
        int brow0, brow1;
        if (MODE == 1) { const int f0 = cgp * 16, t = f0 >> 7, r = f0 & 127; brow0 = 256 * t + r; brow1 = brow0 + 128; }
        else { brow0 = cgp * 32; brow1 = brow0 + 16; }
        const bf16_t* ap = A + (size_t)(row0 + (lane & 15)) * K + k0 + 8 * (lane >> 4);
        const bf16_t* b0p = Bt + (size_t)(brow0 + (lane & 15)) * K + k0 + 8 * (lane >> 4);
        const bf16_t* b1p = Bt + (size_t)(brow1 + (lane & 15)) * K + k0 + 8 * (lane >> 4);
        f32x4 c0 = {0.f, 0.f, 0.f, 0.f}, c1 = {0.f, 0.f, 0.f, 0.f};
#pragma unroll 4
        for (int s = 0; s < nks; ++s) {
            const bf16x8 a = *(const bf16x8*)(ap + 32 * s), b0 = *(const bf16x8*)(b0p + 32 * s), b1 = *(const bf16x8*)(b1p + 32 * s);
            c0 = __builtin_amdgcn_mfma_f32_16x16x32_bf16(b0, a, c0, 0, 0, 0);
            c1 = __builtin_amdgcn_mfma_f32_16x16x32_bf16(b1, a, c1, 0, 0, 0);
        }
        red[(wid * 2 + 0) * 64 + lane] = c0; red[(wid * 2 + 1) * 64 + lane] = c1;
        __syncthreads();
        if (MODE == 1) {
            if (tid < 64) {
                f32x4 g = {0.f, 0.f, 0.f, 0.f}, u = {0.f, 0.f, 0.f, 0.f};
#pragma unroll
                for (int w = 0; w < 8; ++w) { g += red[(w * 2 + 0) * 64 + tid]; u += red[(w * 2 + 1) * 64 + tid]; }
                const int m = tid & 15, n4 = 4 * (tid >> 4);
                u32x2 w2; w2.x = cvt_pk_bf16(silu_mul(g[0], u[0]), silu_mul(g[1], u[1])); w2.y = cvt_pk_bf16(silu_mul(g[2], u[2]), silu_mul(g[3], u[3]));
                *(u32x2*)(O + (size_t)(row0 + m) * DFF + cgp * 16 + n4) = w2;
            }
        } else {
            if (tid < 128) {
                const int ct = tid >> 6, ln = tid & 63;
                f32x4 v = {0.f, 0.f, 0.f, 0.f};
#pragma unroll
                for (int w = 0; w < 8; ++w) v += red[(w * 2 + ct) * 64 + ln];
                const int m = ln & 15, col = cgp * 32 + ct * 16 + 4 * (ln >> 4);
                if (MODE == 0) { u32x2 w2; w2.x = cvt_pk_bf16(v[0], v[1]); w2.y = cvt_pk_bf16(v[2], v[3]); *(u32x2*)(O + (size_t)(row0 + m) * ldc + col) = w2; }
                else { const size_t o = (size_t)(row0 + m) * 1024 + col; const u32x2 yv = *(const u32x2*)(Y + o);
                    f32x4 z; z[0] = ALPHA * bflo(yv.x) + scale * v[0]; z[1] = ALPHA * bfhi(yv.x) + scale * v[1]; z[2] = ALPHA * bflo(yv.y) + scale * v[2]; z[3] = ALPHA * bfhi(yv.y) + scale * v[3];
                    *(f32x4*)(Z + o) = z; }
            }
        }
        __syncthreads();
    }
}

__device__ __forceinline__ void ln_phase(const float* Z, bf16_t* Y, const float* g, const float* b, float* outf) {
    const int tid = otid(), wid = tid >> 6, lane = tid & 63;
    f32x4 g4[4], b4[4];
#pragma unroll
    for (int j = 0; j < 4; ++j) { g4[j] = *(const f32x4*)(g + 256 * j + 4 * lane); b4[j] = *(const f32x4*)(b + 256 * j + 4 * lane); }
    for (int row = obid() * 8 + wid; row < MT; row += ogrid() * 8) {
        f32x4 v[4]; float s = 0.f;
#pragma unroll
        for (int j = 0; j < 4; ++j) { v[j] = *(const f32x4*)(Z + (size_t)row * 1024 + 256 * j + 4 * lane); s += (v[j][0] + v[j][1]) + (v[j][2] + v[j][3]); }
        const float mean = wave_sum(s) * (1.0f / 1024.0f);
        float q = 0.f;
#pragma unroll
        for (int j = 0; j < 4; ++j) { v[j] -= mean; q += (v[j][0] * v[j][0] + v[j][1] * v[j][1]) + (v[j][2] * v[j][2] + v[j][3] * v[j][3]); }
        const float rstd = rsqrtf(wave_sum(q) * (1.0f / 1024.0f) + LN_EPS);
#pragma unroll
        for (int j = 0; j < 4; ++j) { const f32x4 y = v[j] * rstd * g4[j] + b4[j];
            if (outf) *(f32x4*)(outf + (size_t)row * 1024 + 256 * j + 4 * lane) = y;
            u32x2 w; w.x = cvt_pk_bf16(y[0], y[1]); w.y = cvt_pk_bf16(y[2], y[3]); *(u32x2*)(Y + (size_t)row * 1024 + 256 * j + 4 * lane) = w; }
    }
}

__device__ __forceinline__ void tr_job(LAS unsigned char* lds, const float* src, int Nsrc, int K, bf16_t* dst, int Ndst, bool gu) {
    LAS float* t = (LAS float*)lds;
    const int tid = otid(), nkt = K >> 6, ntiles = nkt * (Ndst >> 6);
    for (int tile = obid(); tile < ntiles; tile += ogrid()) {
        const int tk = tile % nkt, tn = tile / nkt, n0 = tn * 64, k0 = tk * 64;
        int sc0 = n0;
        if (gu) { const int tt = n0 >> 8, r = n0 & 255; sc0 = (r < 128) ? 128 * tt + r : DFF + 128 * tt + (r - 128); }
#pragma unroll
        for (int j = 0; j < 2; ++j) { const int kr = (tid >> 4) + 32 * j, c = (tid & 15) * 4;
            const f32x4 v = *(const f32x4*)(src + (size_t)(k0 + kr) * Nsrc + sc0 + c);
            t[kr * 65 + c] = v[0]; t[kr * 65 + c + 1] = v[1]; t[kr * 65 + c + 2] = v[2]; t[kr * 65 + c + 3] = v[3]; }
        __syncthreads();
        { const int n = tid >> 3, kk = (tid & 7) * 8; u32x4 w;
            w.x = cvt_pk_bf16(t[(kk + 0) * 65 + n], t[(kk + 1) * 65 + n]); w.y = cvt_pk_bf16(t[(kk + 2) * 65 + n], t[(kk + 3) * 65 + n]);
            w.z = cvt_pk_bf16(t[(kk + 4) * 65 + n], t[(kk + 5) * 65 + n]); w.w = cvt_pk_bf16(t[(kk + 6) * 65 + n], t[(kk + 7) * 65 + n]);
            *(u32x4*)(dst + (size_t)(n0 + n) * K + k0 + kk) = w; }
        __syncthreads();
    }
}
__device__ __forceinline__ void cvt_job(const float* src, bf16_t* dst, size_t n) {
    for (size_t i = ((size_t)obid() * 512 + otid()) * 8; i < n; i += (size_t)ogrid() * 512 * 8) {
        const f32x4 a = *(const f32x4*)(src + i), b = *(const f32x4*)(src + i + 4);
        u32x4 w; w.x = cvt_pk_bf16(a[0], a[1]); w.y = cvt_pk_bf16(a[2], a[3]); w.z = cvt_pk_bf16(b[0], b[1]); w.w = cvt_pk_bf16(b[2], b[3]);
        *(u32x4*)(dst + i) = w;
    }
}

constexpr int KS_STRIDE = 72, VT_STRIDE = 264, KS_BYTES = 256 * KS_STRIDE * 2;

__device__ __forceinline__ void mixer_prompt(LAS unsigned char* lds, int l, const bf16_t* P, bf16_t* ZM, const float* convw, const float* sinks, float* out) {
    const int tid = otid(), wid = tid >> 6, lane = tid & 63, r = lane & 31, hh = lane >> 5;
    LAS bf16_t* VTs = (LAS bf16_t*)(lds + KS_BYTES);
    for (int item = obid(); item < 256; item += ogrid()) {
        const int b = item >> 7, blk = (item & 127) >> 1, kvh = item & 1;
        const int rowk0 = b * SEQ + (blk - 1) * 128;
        __syncthreads();
#pragma unroll
        for (int j = 0; j < 4; ++j) {
            const int c = tid + 512 * j, key = c >> 3, part = c & 7;
            const bool valid = (blk > 0) || (key >= 128);
            u32x4 kv = {0u, 0u, 0u, 0u}, vv = {0u, 0u, 0u, 0u};
            if (valid) { const bf16_t* pr = P + (size_t)(rowk0 + key) * INC + 2048 + kvh * 64 + part * 8; kv = *(const u32x4*)pr; vv = *(const u32x4*)(pr + 128); }
            *(LAS u32x4*)(lds + (key * KS_STRIDE + part * 8) * 2) = kv;
            LAS bf16_t* vp = VTs + (part * 8) * VT_STRIDE + key;
            vp[0 * VT_STRIDE] = (bf16_t)(vv.x & 0xffff); vp[1 * VT_STRIDE] = (bf16_t)(vv.x >> 16); vp[2 * VT_STRIDE] = (bf16_t)(vv.y & 0xffff); vp[3 * VT_STRIDE] = (bf16_t)(vv.y >> 16);
            vp[4 * VT_STRIDE] = (bf16_t)(vv.z & 0xffff); vp[5 * VT_STRIDE] = (bf16_t)(vv.z >> 16); vp[6 * VT_STRIDE] = (bf16_t)(vv.w & 0xffff); vp[7 * VT_STRIDE] = (bf16_t)(vv.w >> 16);
            if (blk == 63 && key >= 128) {
                const size_t o = ((((size_t)l * 2 + b) * 128 + (key - 128)) * 2 + kvh) * 64 + part * 8;
                f32x4 k0v = {bflo(kv.x), bfhi(kv.x), bflo(kv.y), bfhi(kv.y)}, k1v = {bflo(kv.z), bfhi(kv.z), bflo(kv.w), bfhi(kv.w)};
                f32x4 v0v = {bflo(vv.x), bfhi(vv.x), bflo(vv.y), bfhi(vv.y)}, v1v = {bflo(vv.z), bfhi(vv.z), bflo(vv.w), bfhi(vv.w)};
                *(f32x4*)(out + OUT_WKP + o) = k0v; *(f32x4*)(out + OUT_WKP + o + 4) = k1v;
                *(f32x4*)(out + OUT_WVP + o) = v0v; *(f32x4*)(out + OUT_WVP + o + 4) = v1v;
            }
        }
        __syncthreads();
#pragma unroll 1
        for (int wi2 = 0; wi2 < 2; ++wi2) {
            const int wi = wid * 2 + wi2, hq = wi >> 2, rt = wi & 3, a0 = rt * 32, qh = kvh * 4 + hq;
            const int qrow = b * SEQ + blk * 128 + a0 + r;
            bf16x8 qf[4];
#pragma unroll
            for (int s = 0; s < 4; ++s) qf[s] = *(const bf16x8*)(P + (size_t)qrow * INC + 1536 + qh * 64 + 16 * s + 8 * hh);
            f32x16 S[5];
#pragma unroll
            for (int kt5 = 0; kt5 < 5; ++kt5) {
#pragma unroll
                for (int e = 0; e < 16; ++e) S[kt5][e] = 0.f;
#pragma unroll
                for (int s = 0; s < 4; ++s) {
                    const bf16x8 kf = *(const LAS bf16x8*)(lds + (((rt + kt5) * 32 + r) * KS_STRIDE + 16 * s + 8 * hh) * 2);
                    S[kt5] = __builtin_amdgcn_mfma_f32_32x32x16_bf16(kf, qf[s], S[kt5], 0, 0, 0);
                }
            }
            const float sink = sinks[l * 8 + qh];
            float mx = -INFINITY;
            const int a = a0 + r;
#pragma unroll
            for (int kt5 = 0; kt5 < 5; ++kt5)
#pragma unroll
                for (int e = 0; e < 16; ++e) {
                    const int c = (rt + kt5) * 32 + (e & 3) + 8 * (e >> 2) + 4 * hh, rel = 128 + a - c;
                    const bool valid = (rel >= 0) && (rel <= 128) && ((blk > 0) || (c >= 128));
                    const float sv = valid ? S[kt5][e] * 0.125f : -INFINITY;
                    S[kt5][e] = sv; mx = fmaxf(mx, sv);
                }
            mx = fmaxf(mx, __shfl_xor(mx, 32));
            const float mm = fmaxf(mx, sink);
            float sum = 0.f;
#pragma unroll
            for (int kt5 = 0; kt5 < 5; ++kt5)
#pragma unroll
                for (int e = 0; e < 16; ++e) { const float pv = __expf(S[kt5][e] - mm); S[kt5][e] = pv; sum += pv; }
            sum += __shfl_xor(sum, 32);
            const float inv = 1.0f / (sum + __expf(sink - mm));
            f32x16 O[2];
#pragma unroll
            for (int mt = 0; mt < 2; ++mt)
#pragma unroll
                for (int e = 0; e < 16; ++e) O[mt][e] = 0.f;
#pragma unroll
            for (int kt5 = 0; kt5 < 5; ++kt5)
#pragma unroll
                for (int s2 = 0; s2 < 2; ++s2) {
                    u32x4 pw; pw.x = cvt_pk_bf16(S[kt5][8 * s2 + 0], S[kt5][8 * s2 + 1]); pw.y = cvt_pk_bf16(S[kt5][8 * s2 + 2], S[kt5][8 * s2 + 3]);
                    pw.z = cvt_pk_bf16(S[kt5][8 * s2 + 4], S[kt5][8 * s2 + 5]); pw.w = cvt_pk_bf16(S[kt5][8 * s2 + 6], S[kt5][8 * s2 + 7]);
                    const bf16x8 pf = __builtin_bit_cast(bf16x8, pw);
                    const int keybase = (rt + kt5) * 32 + 16 * s2 + 4 * hh;
#pragma unroll
                    for (int mt = 0; mt < 2; ++mt) {
                        const LAS bf16_t* vp = VTs + (mt * 32 + r) * VT_STRIDE + keybase;
                        const u32x2 lo = *(const LAS u32x2*)vp, hi = *(const LAS u32x2*)(vp + 8);
                        u32x4 vw; vw.x = lo.x; vw.y = lo.y; vw.z = hi.x; vw.w = hi.y;
                        O[mt] = __builtin_amdgcn_mfma_f32_32x32x16_bf16(__builtin_bit_cast(bf16x8, vw), pf, O[mt], 0, 0, 0);
                    }
                }
#pragma unroll
            for (int mt = 0; mt < 2; ++mt)
#pragma unroll
                for (int gq = 0; gq < 4; ++gq) {
                    u32x2 w; w.x = cvt_pk_bf16(O[mt][4 * gq + 0] * inv, O[mt][4 * gq + 1] * inv); w.y = cvt_pk_bf16(O[mt][4 * gq + 2] * inv, O[mt][4 * gq + 3] * inv);
                    *(u32x2*)(ZM + (size_t)qrow * 1024 + 512 + qh * 64 + mt * 32 + 8 * gq + 4 * hh) = w;
                }
        }
        {
            const int ch0 = kvh * 256 + (tid & 31) * 8, rgp = tid >> 5, p0 = blk * 128 + rgp * 8;
            float w0[8], w1[8], w2[8], u1[8], u2[8];
#pragma unroll
            for (int e = 0; e < 8; ++e) { w0[e] = convw[(l * 3 + 0) * 512 + ch0 + e]; w1[e] = convw[(l * 3 + 1) * 512 + ch0 + e]; w2[e] = convw[(l * 3 + 2) * 512 + ch0 + e]; u1[e] = 0.f; u2[e] = 0.f; }
#pragma unroll
            for (int i = -2; i < 8; ++i) {
                const int pos = p0 + i;
                float uu[8];
#pragma unroll
                for (int e = 0; e < 8; ++e) uu[e] = 0.f;
                const bf16_t* pr = P + (size_t)(b * SEQ + pos) * INC + ch0;
                if (pos >= 0) {
                    const u32x4 cgv = *(const u32x4*)(pr + 512), hcv = *(const u32x4*)(pr + 1024);
                    uu[0] = bflo(cgv.x) * bflo(hcv.x); uu[1] = bfhi(cgv.x) * bfhi(hcv.x); uu[2] = bflo(cgv.y) * bflo(hcv.y); uu[3] = bfhi(cgv.y) * bfhi(hcv.y);
                    uu[4] = bflo(cgv.z) * bflo(hcv.z); uu[5] = bfhi(cgv.z) * bfhi(hcv.z); uu[6] = bflo(cgv.w) * bflo(hcv.w); uu[7] = bfhi(cgv.w) * bfhi(hcv.w);
                }
                if (i >= 0) {
                    const u32x4 bgv = *(const u32x4*)pr;
                    float bg[8] = {bflo(bgv.x), bfhi(bgv.x), bflo(bgv.y), bfhi(bgv.y), bflo(bgv.z), bfhi(bgv.z), bflo(bgv.w), bfhi(bgv.w)};
                    float z[8];
#pragma unroll
                    for (int e = 0; e < 8; ++e) z[e] = bg[e] * (w0[e] * u2[e] + w1[e] * u1[e] + w2[e] * uu[e]);
                    u32x4 w; w.x = cvt_pk_bf16(z[0], z[1]); w.y = cvt_pk_bf16(z[2], z[3]); w.z = cvt_pk_bf16(z[4], z[5]); w.w = cvt_pk_bf16(z[6], z[7]);
                    *(u32x4*)(ZM + (size_t)(b * SEQ + pos) * 1024 + ch0) = w;
                    if (blk == 63 && rgp == 15 && i >= 6) {
                        float* oc = out + OUT_CVP + (((size_t)l * 2 + b) * 2 + (i - 6)) * 512 + ch0;
                        f32x4 o0 = {uu[0], uu[1], uu[2], uu[3]}, o1 = {uu[4], uu[5], uu[6], uu[7]};
                        *(f32x4*)oc = o0; *(f32x4*)(oc + 4) = o1;
                    }
                }
#pragma unroll
                for (int e = 0; e < 8; ++e) { u2[e] = u1[e]; u1[e] = uu[e]; }
            }
        }
    }
}

__device__ __forceinline__ void mixer_sample(LAS unsigned char* lds, int l, const bf16_t* P, bf16_t* ZM, const float* convw, const float* sinks, const float* cwk, const float* cwv, const float* sconv, float* out) {
    const int tid = otid(), wid = tid >> 6, lane = tid & 63;
    LAS float* Kc = (LAS float*)lds;
    LAS float* Vc = (LAS float*)(lds + 33792);
    LAS float* SC = (LAS float*)(lds + 67584);
    LAS float* QS = (LAS float*)(lds + 69888);
    for (int item = obid(); item < 256; item += ogrid()) {
        const int bs = item >> 1, kvh = item & 1;
        const bf16_t* pr = P + (size_t)(TP + bs) * INC;
        __syncthreads();
#pragma unroll
        for (int j = 0; j < 4; ++j) {
            const int c = tid + 512 * j, key = c >> 4, part = c & 15;
            const size_t src = ((((size_t)l * 128 + bs) * 128 + key) * 2 + kvh) * 64 + part * 4;
            const f32x4 kv = *(const f32x4*)(cwk + src), vv = *(const f32x4*)(cwv + src);
#pragma unroll
            for (int e = 0; e < 4; ++e) { Kc[key * 65 + part * 4 + e] = kv[e]; Vc[key * 65 + part * 4 + e] = vv[e]; }
            if (key >= 1) { const size_t o = ((((size_t)l * 128 + bs) * 128 + (key - 1)) * 2 + kvh) * 64 + part * 4;
                *(f32x4*)(out + OUT_WKS + o) = kv; *(f32x4*)(out + OUT_WVS + o) = vv; }
        }
        if (tid < 128) {
            const int d = tid & 63, isv = tid >> 6;
            const float x = bf2f(pr[2048 + isv * 128 + kvh * 64 + d]);
            (isv ? Vc : Kc)[128 * 65 + d] = x;
            out[(isv ? OUT_WVS : OUT_WKS) + ((((size_t)l * 128 + bs) * 128 + 127) * 2 + kvh) * 64 + d] = x;
        } else if (tid < 384) {
            const int i = tid - 128;
            QS[i] = bf2f(pr[1536 + kvh * 256 + i]);
        }
        __syncthreads();
        for (int idx = tid; idx < 4 * 129; idx += 512) {
            const int hq = idx / 129, key = idx - hq * 129;
            float s = 0.f;
#pragma unroll 16
            for (int d = 0; d < 64; ++d) s += QS[hq * 64 + d] * Kc[key * 65 + d];
            SC[hq * 132 + key] = s * 0.125f;
        }
        __syncthreads();
        if (wid < 4) {
            const float sink = sinks[l * 8 + kvh * 4 + wid];
            const float s0 = SC[wid * 132 + lane], s1 = SC[wid * 132 + 64 + lane], s2 = (lane == 0) ? SC[wid * 132 + 128] : -INFINITY;
            const float mm = fmaxf(wave_max(fmaxf(fmaxf(s0, s1), s2)), sink);
            const float p0 = __expf(s0 - mm), p1 = __expf(s1 - mm), p2 = __expf(s2 - mm);
            const float inv = 1.0f / (wave_sum(p0 + p1 + p2) + __expf(sink - mm));
            SC[wid * 132 + lane] = p0 * inv; SC[wid * 132 + 64 + lane] = p1 * inv; if (lane == 0) SC[wid * 132 + 128] = p2 * inv;
        }
        __syncthreads();
        if (tid < 256) {
            const int hq = tid >> 6, d = tid & 63;
            float o = 0.f;
#pragma unroll 8
            for (int key = 0; key < 129; ++key) o += SC[hq * 132 + key] * Vc[key * 65 + d];
            ZM[(size_t)(TP + bs) * 1024 + 512 + (kvh * 4 + hq) * 64 + d] = f2bf(o);
        } else {
            const int c = kvh * 256 + (tid - 256);
            const float bg = bf2f(pr[c]), u = bf2f(pr[512 + c]) * bf2f(pr[1024 + c]);
            const float s0 = sconv[(((size_t)l * 128 + bs) * 2 + 0) * 512 + c], s1 = sconv[(((size_t)l * 128 + bs) * 2 + 1) * 512 + c];
            const float z = bg * (convw[(l * 3 + 0) * 512 + c] * s0 + convw[(l * 3 + 1) * 512 + c] * s1 + convw[(l * 3 + 2) * 512 + c] * u);
            ZM[(size_t)(TP + bs) * 1024 + c] = f2bf(z);
            out[OUT_CVS + (((size_t)l * 128 + bs) * 2 + 0) * 512 + c] = s1;
            out[OUT_CVS + (((size_t)l * 128 + bs) * 2 + 1) * 512 + c] = u;
        }
    }
}

__device__ __forceinline__ void cross_prompt(LAS unsigned char* lds, int l, const bf16_t* Q, const bf16_t* MK, const bf16_t* VT, bf16_t* O) {
    const int tid = otid(), wid = tid >> 6, lane = tid & 63, r = lane & 31, hh = lane >> 5;
    LAS bf16_t* VTs = (LAS bf16_t*)(lds + KS_BYTES);
    for (int item = obid(); item < 256; item += ogrid()) {
        const int b = item >> 7, qt = (item & 127) >> 2, h = item & 3;
        const int qrow = b * SEQ + qt * 256 + wid * 32 + r;
        const bf16_t* mk = MK + (size_t)l * 524288 + (size_t)(b * 256) * 1024 + h * 256;
        const bf16_t* vt = VT + ((size_t)((l * 2 + b) * 4 + h)) * 65536;
        f32x16 S[8];
#pragma unroll
        for (int kt = 0; kt < 8; ++kt)
#pragma unroll
            for (int e = 0; e < 16; ++e) S[kt][e] = 0.f;
#pragma unroll 1
        for (int ch = 0; ch < 4; ++ch) {
            __syncthreads();
#pragma unroll
            for (int j = 0; j < 4; ++j) { const int c = tid + 512 * j, key = c >> 3, part = c & 7;
                *(LAS u32x4*)(lds + (key * KS_STRIDE + part * 8) * 2) = *(const u32x4*)(mk + (size_t)key * 1024 + ch * 64 + part * 8); }
            bf16x8 qf[4];
#pragma unroll
            for (int s = 0; s < 4; ++s) qf[s] = *(const bf16x8*)(Q + (size_t)qrow * 1024 + h * 256 + ch * 64 + 16 * s + 8 * hh);
            __syncthreads();
#pragma unroll
            for (int kt = 0; kt < 8; ++kt)
#pragma unroll
                for (int s = 0; s < 4; ++s) {
                    const bf16x8 kf = *(const LAS bf16x8*)(lds + ((kt * 32 + r) * KS_STRIDE + 16 * s + 8 * hh) * 2);
                    S[kt] = __builtin_amdgcn_mfma_f32_32x32x16_bf16(kf, qf[s], S[kt], 0, 0, 0);
                }
        }
        float mx = -INFINITY;
#pragma unroll
        for (int kt = 0; kt < 8; ++kt)
#pragma unroll
            for (int e = 0; e < 16; ++e) mx = fmaxf(mx, S[kt][e]);
        mx = fmaxf(mx, __shfl_xor(mx, 32));
        float sum = 0.f;
        bf16x8 pf[8][2];
#pragma unroll
        for (int kt = 0; kt < 8; ++kt) {
#pragma unroll
            for (int e = 0; e < 16; ++e) { const float pv = __expf((S[kt][e] - mx) * 0.0625f); S[kt][e] = pv; sum += pv; }
#pragma unroll
            for (int s2 = 0; s2 < 2; ++s2) {
                u32x4 pw; pw.x = cvt_pk_bf16(S[kt][8 * s2 + 0], S[kt][8 * s2 + 1]); pw.y = cvt_pk_bf16(S[kt][8 * s2 + 2], S[kt][8 * s2 + 3]);
                pw.z = cvt_pk_bf16(S[kt][8 * s2 + 4], S[kt][8 * s2 + 5]); pw.w = cvt_pk_bf16(S[kt][8 * s2 + 6], S[kt][8 * s2 + 7]);
                pf[kt][s2] = __builtin_bit_cast(bf16x8, pw);
            }
        }
        sum += __shfl_xor(sum, 32);
        const float inv = 1.0f / sum;
#pragma unroll 1
        for (int ch = 0; ch < 4; ++ch) {
            __syncthreads();
#pragma unroll
            for (int j = 0; j < 4; ++j) { const int c = tid + 512 * j, dim = c >> 5, part = c & 31;
                *(LAS u32x4*)(lds + KS_BYTES + (dim * VT_STRIDE + part * 8) * 2) = *(const u32x4*)(vt + (size_t)(ch * 64 + dim) * 256 + part * 8); }
            __syncthreads();
            f32x16 Oa[2];
#pragma unroll
            for (int mt = 0; mt < 2; ++mt)
#pragma unroll
                for (int e = 0; e < 16; ++e) Oa[mt][e] = 0.f;
#pragma unroll
            for (int kt = 0; kt < 8; ++kt)
#pragma unroll
                for (int s2 = 0; s2 < 2; ++s2)
#pragma unroll
                    for (int mt = 0; mt < 2; ++mt) {
                        const LAS bf16_t* vp = VTs + (mt * 32 + r) * VT_STRIDE + kt * 32 + 16 * s2 + 4 * hh;
                        const u32x2 lo = *(const LAS u32x2*)vp, hi = *(const LAS u32x2*)(vp + 8);
                        u32x4 vw; vw.x = lo.x; vw.y = lo.y; vw.z = hi.x; vw.w = hi.y;
                        Oa[mt] = __builtin_amdgcn_mfma_f32_32x32x16_bf16(__builtin_bit_cast(bf16x8, vw), pf[kt][s2], Oa[mt], 0, 0, 0);
                    }
#pragma unroll
            for (int mt = 0; mt < 2; ++mt)
#pragma unroll
                for (int gq = 0; gq < 4; ++gq) {
                    u32x2 w; w.x = cvt_pk_bf16(Oa[mt][4 * gq + 0] * inv, Oa[mt][4 * gq + 1] * inv); w.y = cvt_pk_bf16(Oa[mt][4 * gq + 2] * inv, Oa[mt][4 * gq + 3] * inv);
                    *(u32x2*)(O + (size_t)qrow * 1024 + h * 256 + ch * 64 + mt * 32 + 8 * gq + 4 * hh) = w;
                }
        }
    }
}

__device__ __forceinline__ void cross_sample(LAS unsigned char* lds, int l, const bf16_t* Q, const float* cmk, const float* cmv, bf16_t* O) {
    const int tid = otid(), wid = tid >> 6, lane = tid & 63;
    LAS float* SC = (LAS float*)lds;
    LAS f32x4* RED = (LAS f32x4*)(lds + 1024);
    for (int item = obid(); item < 512; item += ogrid()) {
        const int bs = item >> 2, h = item & 3;
        const u32x2 qw = *(const u32x2*)(Q + (size_t)(TP + bs) * 1024 + h * 256 + 4 * lane);
        const f32x4 qv = {bflo(qw.x), bfhi(qw.x), bflo(qw.y), bfhi(qw.y)};
        const float* kb = cmk + (((size_t)l * 128 + bs) * 256) * 1024 + h * 256 + 4 * lane;
        const float* vb = cmv + (((size_t)l * 128 + bs) * 256) * 1024 + h * 256 + 4 * lane;
        __syncthreads();
        float mys = 0.f;
#pragma unroll 1
        for (int kk = 0; kk < 32; kk += 8) {
            f32x4 kv[8];
#pragma unroll
            for (int i = 0; i < 8; ++i) kv[i] = *(const f32x4*)(kb + (size_t)(wid * 32 + kk + i) * 1024);
#pragma unroll
            for (int i = 0; i < 8; ++i) {
                const float d = wave_sum((kv[i][0] * qv[0] + kv[i][1] * qv[1]) + (kv[i][2] * qv[2] + kv[i][3] * qv[3]));
                if (lane == kk + i) mys = d;
            }
        }
        if (lane < 32) SC[wid * 32 + lane] = mys * 0.0625f;
        __syncthreads();
        const float s0 = SC[lane], s1 = SC[lane + 64], s2 = SC[lane + 128], s3 = SC[lane + 192];
        const float mx = wave_max(fmaxf(fmaxf(s0, s1), fmaxf(s2, s3)));
        const float inv = 1.0f / wave_sum((__expf(s0 - mx) + __expf(s1 - mx)) + (__expf(s2 - mx) + __expf(s3 - mx)));
        f32x4 acc = {0.f, 0.f, 0.f, 0.f};
#pragma unroll 1
        for (int kk = 0; kk < 32; kk += 8) {
            f32x4 vv[8];
#pragma unroll
            for (int i = 0; i < 8; ++i) vv[i] = *(const f32x4*)(vb + (size_t)(wid * 32 + kk + i) * 1024);
#pragma unroll
            for (int i = 0; i < 8; ++i) { const float pv = __expf(SC[wid * 32 + kk + i] - mx); acc += vv[i] * pv; }
        }
        RED[wid * 64 + lane] = acc;
        __syncthreads();
        if (tid < 64) {
            f32x4 o = {0.f, 0.f, 0.f, 0.f};
#pragma unroll
            for (int w = 0; w < 8; ++w) o += RED[w * 64 + tid];
            u32x2 w2; w2.x = cvt_pk_bf16(o[0] * inv, o[1] * inv); w2.y = cvt_pk_bf16(o[2] * inv, o[3] * inv);
            *(u32x2*)(O + (size_t)(TP + bs) * 1024 + h * 256 + 4 * tid) = w2;
        }
    }
}

__device__ __forceinline__ const void* karg(int idx) {
    const __attribute__((address_space(4))) unsigned char* ka = (const __attribute__((address_space(4))) unsigned char*)__builtin_amdgcn_kernarg_segment_ptr();
    asm volatile("" : "+s"(ka));
    return *(const void* const __attribute__((address_space(4)))*)(ka + 8 * idx);
}
#define KIN(i) ((const float*)karg(i))
#define KOUT ((float*)karg(22))
#define KWS ((unsigned char*)karg(23))
#define WS_PTRS \
    unsigned char* ws = KWS; \
    bf16_t* Y = (bf16_t*)(ws + WS_Y); float* Z = (float*)(ws + WS_Z); \
    bf16_t* R1 = (bf16_t*)(ws + WS_R1); bf16_t* R2 = (bf16_t*)(ws + WS_R2); \
    unsigned char* wl = ws + WS_W + (size_t)L * WL_SIZE; \
    const int G = ogrid(), bx = obid();

template <int L, int F>
__device__ __forceinline__ void ffn_block(const Params& p, LAS unsigned char* lds, cg::grid_group& grid) {
    WS_PTRS
    const bf16_t* wgu = (const bf16_t*)(wl + (F ? WL_GU2 : WL_GU1));
    const bf16_t* wdn = (const bf16_t*)(wl + (F ? WL_D2 : WL_D1));
    { pg8::Gemm g{Y, wgu, TP, 5632, 1024}; pg8::StaticOrder S; S.init(TP, 5632, G, bx);
      EpiSwiglu E{R1}; pg8::gemm_phase<EpiSwiglu>(lds, g, S, E);
      sample_gemm<1>(lds, Y + (size_t)TP * 1024, 1024, wgu, 5632, R1 + (size_t)TP * DFF, DFF, nullptr, nullptr, 0.f); }
    grid.sync();
    { pg8::Gemm g{R1, wdn, TP, 1024, DFF}; pg8::StaticOrder S; S.init(TP, 1024, G, bx);
      EpiRes E{Y, Z, 0.5f}; pg8::gemm_phase<EpiRes>(lds, g, S, E);
      sample_gemm<2>(lds, R1 + (size_t)TP * DFF, DFF, wdn, 1024, nullptr, 0, Y + (size_t)TP * 1024, Z + (size_t)TP * 1024, 0.5f); }
    grid.sync();
    constexpr int li = F ? 3 : 0;
    ln_phase(Z, Y, KIN(8) + (L * 4 + li) * 1024, KIN(9) + (L * 4 + li) * 1024, (L == 1 && F == 1) ? KOUT : nullptr);
    grid.sync();
}

template <int L>
__device__ __forceinline__ void mix_block(const Params& p, LAS unsigned char* lds, cg::grid_group& grid) {
    WS_PTRS
    bf16_t* MK = (bf16_t*)(ws + WS_MK); bf16_t* VT = (bf16_t*)(ws + WS_VT);
    { pg8::Gemm g{Y, (const bf16_t*)(wl + WL_IN), TP, INC, 1024}; pg8::StaticOrder S; S.init(TP, INC, G, bx);
      EpiBf16 E{R1, INC}; pg8::gemm_phase<EpiBf16>(lds, g, S, E);
      sample_gemm<0>(lds, Y + (size_t)TP * 1024, 1024, (const bf16_t*)(wl + WL_IN), INC, R1 + (size_t)TP * INC, INC, nullptr, nullptr, 0.f); }
    grid.sync();
    mixer_prompt(lds, L, R1, R2, KIN(13), KIN(14), KOUT);
    mixer_sample(lds, L, R1, R2, KIN(13), KIN(14), KIN(3), KIN(4), KIN(5), KOUT);
    grid.sync();
    { pg8::Gemm g{R2, (const bf16_t*)(wl + WL_OUT), TP, 1024, 1024}; pg8::StaticOrder S; S.init(TP, 1024, G, bx);
      EpiRes E{Y, Z, 1.0f}; pg8::gemm_phase<EpiRes>(lds, g, S, E);
      sample_gemm<2>(lds, R2 + (size_t)TP * 1024, 1024, (const bf16_t*)(wl + WL_OUT), 1024, nullptr, 0, Y + (size_t)TP * 1024, Z + (size_t)TP * 1024, 1.0f); }
    grid.sync();
    ln_phase(Z, Y, KIN(8) + (L * 4 + 1) * 1024, KIN(9) + (L * 4 + 1) * 1024, nullptr);
    grid.sync();
    { pg8::Gemm g{Y, (const bf16_t*)(wl + WL_CQ), TP, 1024, 1024}; pg8::StaticOrder S; S.init(TP, 1024, G, bx);
      EpiBf16 E{R1, 1024}; pg8::gemm_phase<EpiBf16>(lds, g, S, E);
      sample_gemm<0>(lds, Y + (size_t)TP * 1024, 1024, (const bf16_t*)(wl + WL_CQ), 1024, R1 + (size_t)TP * 1024, 1024, nullptr, nullptr, 0.f); }
    grid.sync();
    cross_prompt(lds, L, R1, MK, VT, R2);
    cross_sample(lds, L, R1, KIN(6), KIN(7), R2);
    grid.sync();
    { pg8::Gemm g{R2, (const bf16_t*)(wl + WL_CO), TP, 1024, 1024}; pg8::StaticOrder S; S.init(TP, 1024, G, bx);
      EpiRes E{Y, Z, 1.0f}; pg8::gemm_phase<EpiRes>(lds, g, S, E);
      sample_gemm<2>(lds, R2 + (size_t)TP * 1024, 1024, (const bf16_t*)(wl + WL_CO), 1024, nullptr, 0, Y + (size_t)TP * 1024, Z + (size_t)TP * 1024, 1.0f); }
    grid.sync();
    ln_phase(Z, Y, KIN(8) + (L * 4 + 2) * 1024, KIN(9) + (L * 4 + 2) * 1024, nullptr);
    grid.sync();
}

template <int L>
__device__ __forceinline__ void prep_layer(const Params& p, LAS unsigned char* lds) {
    unsigned char* ws = KWS;
    unsigned char* wl = ws + WS_W + (size_t)L * WL_SIZE;
    bf16_t* MKVW = (bf16_t*)(ws + WS_MKVW);
    tr_job(lds, KIN(10) + (size_t)L * 1024 * 5632, 5632, 1024, (bf16_t*)(wl + WL_GU1), 5632, true);
    tr_job(lds, KIN(11) + (size_t)L * 2816 * 1024, 1024, 2816, (bf16_t*)(wl + WL_D1), 1024, false);
    tr_job(lds, KIN(12) + (size_t)L * 1024 * 2304, 2304, 1024, (bf16_t*)(wl + WL_IN), 2304, false);
    tr_job(lds, KIN(15) + (size_t)L * 1024 * 1024, 1024, 1024, (bf16_t*)(wl + WL_OUT), 1024, false);
    tr_job(lds, KIN(16) + (size_t)L * 1024 * 1024, 1024, 1024, (bf16_t*)(wl + WL_CQ), 1024, false);
    tr_job(lds, KIN(19) + (size_t)L * 1024 * 1024, 1024, 1024, (bf16_t*)(wl + WL_CO), 1024, false);
    tr_job(lds, KIN(20) + (size_t)L * 1024 * 5632, 5632, 1024, (bf16_t*)(wl + WL_GU2), 5632, true);
    tr_job(lds, KIN(21) + (size_t)L * 2816 * 1024, 1024, 2816, (bf16_t*)(wl + WL_D2), 1024, false);
    tr_job(lds, KIN(17) + (size_t)L * 1024 * 1024, 1024, 1024, MKVW + (size_t)(L * 2048) * 1024, 1024, false);
    tr_job(lds, KIN(18) + (size_t)L * 1024 * 1024, 1024, 1024, MKVW + (size_t)(L * 2048 + 1024) * 1024, 1024, false);
}

__global__ void __launch_bounds__(512) hymba_fwd(Params p) {
    extern __shared__ __attribute__((aligned(16))) unsigned char smem[];
    LAS unsigned char* lds = (LAS unsigned char*)smem;
    cg::grid_group grid = cg::this_grid();

    prep_layer<0>(p, lds);
    prep_layer<1>(p, lds);
    {
        unsigned char* ws = KWS;
        bf16_t* Y = (bf16_t*)(ws + WS_Y);
        cvt_job(KIN(0), Y, (size_t)TP * 1024);
        cvt_job(KIN(1), Y + (size_t)TP * 1024, (size_t)TS * 1024);
        cvt_job(KIN(2), (bf16_t*)(ws + WS_MEMB), (size_t)512 * 1024);
    }
    grid.sync();

    {
        unsigned char* ws = KWS;
        const int G = ogrid(), bx = obid();
        pg8::Gemm g{(bf16_t*)(ws + WS_MEMB), (bf16_t*)(ws + WS_MKVW), 512, 4096, 1024}; pg8::StaticOrder S; S.init(512, 4096, G, (bx + 128) % G);
        EpiMemKV E{KOUT, (bf16_t*)(ws + WS_MK), (bf16_t*)(ws + WS_VT)};
        pg8::gemm_phase<EpiMemKV>(lds, g, S, E);
    }
    ffn_block<0, 0>(p, lds, grid);
    mix_block<0>(p, lds, grid);
    ffn_block<0, 1>(p, lds, grid);
    ffn_block<1, 0>(p, lds, grid);
    mix_block<1>(p, lds, grid);
    ffn_block<1, 1>(p, lds, grid);
}

extern "C" void kernel_launch(void* const* d_in, const int* in_sizes, int n_in, void* d_out, int out_size, void* d_ws, size_t ws_size, hipStream_t stream) {
    static int grid_blocks = 0;
    if (!grid_blocks) {
        int dev = 0, cus = 0, per_cu = 0;
        hipGetDevice(&dev);
        hipDeviceGetAttribute(&cus, hipDeviceAttributeMultiprocessorCount, dev);
        if (hipFuncSetAttribute((const void*)hymba_fwd, hipFuncAttributeMaxDynamicSharedMemorySize, LDS_BYTES) != hipSuccess) fprintf(stderr, "hipFuncSetAttribute failed\n");
        if (hipOccupancyMaxActiveBlocksPerMultiprocessor(&per_cu, (const void*)hymba_fwd, 512, LDS_BYTES) != hipSuccess || per_cu < 1) { fprintf(stderr, "occupancy query: %d\n", per_cu); per_cu = 1; }
        (void)hipGetLastError();
        grid_blocks = cus > 0 ? cus : 256;
        if (ws_size < WS_END) fprintf(stderr, "workspace too small: %zu < %zu\n", ws_size, (size_t)WS_END);
    }
    Params p{};
    for (int i = 0; i < 22; ++i) p.in[i] = (const float*)d_in[i];
    p.out = (float*)d_out; p.ws = (unsigned char*)d_ws;
    void* args[] = {&p};
    hipError_t e = hipLaunchCooperativeKernel((const void*)hymba_fwd, dim3(grid_blocks), dim3(512), args, LDS_BYTES, stream);
    if (e != hipSuccess) fprintf(stderr, "cooperative launch failed: %s (grid %d)\n", hipGetErrorString(e), grid_blocks);
}
```

```cpp
#include <hip/hip_runtime.h>
#include <hip/hip_cooperative_groups.h>
#include <cstdio>
namespace cg = cooperative_groups;

#define LAS __attribute__((address_space(3)))
typedef unsigned short bf16_t;
typedef short bf16x8 __attribute__((ext_vector_type(8)));
typedef short s16x4 __attribute__((ext_vector_type(4)));
typedef float f32x4 __attribute__((ext_vector_type(4)));
typedef float f32x16 __attribute__((ext_vector_type(16)));
typedef unsigned u32x4 __attribute__((ext_vector_type(4)));
typedef unsigned u32x2 __attribute__((ext_vector_type(2)));

constexpr int TP = 16384, TS = 128, MT = TP + TS, DM = 1024, DFF = 2816, INC = 2304, SEQ = 8192;
constexpr float ALPHA = 1.41421356237309515f;
constexpr float LN_EPS = 1e-5f;
constexpr int LDS_BYTES = 131072 + 16;

constexpr size_t OUT_YP = 0, OUT_YS = 16777216, OUT_WKP = OUT_YS + 131072, OUT_WVP = OUT_WKP + 65536, OUT_CVP = OUT_WVP + 65536,
                 OUT_MKP = OUT_CVP + 4096, OUT_MVP = OUT_MKP + 1048576, OUT_WKS = OUT_MVP + 1048576, OUT_WVS = OUT_WKS + 4194304, OUT_CVS = OUT_WVS + 4194304;

constexpr size_t SZ_GU = (size_t)5632 * 1024 * 2, SZ_DN = (size_t)1024 * 2816 * 2, SZ_IN = (size_t)2304 * 1024 * 2, SZ_SQ = (size_t)1024 * 1024 * 2;
constexpr size_t WL_GU1 = 0, WL_D1 = WL_GU1 + SZ_GU, WL_IN = WL_D1 + SZ_DN, WL_OUT = WL_IN + SZ_IN, WL_CQ = WL_OUT + SZ_SQ, WL_CO = WL_CQ + SZ_SQ,
                 WL_GU2 = WL_CO + SZ_SQ, WL_D2 = WL_GU2 + SZ_GU, WL_SIZE = WL_D2 + SZ_DN;
constexpr size_t WS_W = 0, WS_MKVW = WS_W + 2 * WL_SIZE, WS_MEMB = WS_MKVW + (size_t)4096 * 1024 * 2, WS_MK = WS_MEMB + (size_t)512 * 1024 * 2,
                 WS_VT = WS_MK + (size_t)2 * 512 * 1024 * 2, WS_Y = WS_VT + (size_t)2 * 512 * 1024 * 2, WS_Z = WS_Y + (size_t)MT * 1024 * 2,
                 WS_R1 = WS_Z + (size_t)MT * 1024 * 4, WS_R2 = WS_R1 + (size_t)MT * 2816 * 2, WS_BAR = WS_R2 + (size_t)MT * 1024 * 2, WS_END = WS_BAR + 65536;

struct Params { const float* in[22]; float* out; unsigned char* ws; };

__device__ __forceinline__ unsigned cvt_pk_bf16(float lo, float hi) { unsigned r; asm("v_cvt_pk_bf16_f32 %0, %1, %2" : "=v"(r) : "v"(lo), "v"(hi)); return r; }
__device__ __forceinline__ float bflo(unsigned w) { return __uint_as_float(w << 16); }
__device__ __forceinline__ float bfhi(unsigned w) { return __uint_as_float(w & 0xffff0000u); }
__device__ __forceinline__ float bf2f(bf16_t b) { return __uint_as_float(((unsigned)b) << 16); }
__device__ __forceinline__ bf16_t f2bf(float f) { return (bf16_t)(cvt_pk_bf16(f, 0.f) & 0xffffu); }

__device__ __forceinline__ int otid() { int t = threadIdx.x; asm volatile("" : "+v"(t)); return t; }
__device__ __forceinline__ int obid() { int t = blockIdx.x; asm volatile("" : "+s"(t)); return t; }
__device__ __forceinline__ int ogrid() { int t = gridDim.x; asm volatile("" : "+s"(t)); return t; }
__device__ __forceinline__ float wave_sum(float v) {
#pragma unroll
    for (int o = 32; o >= 1; o >>= 1) v += __shfl_xor(v, o);
    return v;
}
__device__ __forceinline__ float wave_max(float v) {
#pragma unroll
    for (int o = 32; o >= 1; o >>= 1) v = fmaxf(v, __shfl_xor(v, o));
    return v;
}


#define XB_TMO      128
#define XB_XCNT(j)  (256  + 64 * (j))
#define XB_XSUB(j)  (1280 + 64 * (j))
#define XB_XGEN(j)  (2304 + 64 * (j))
#define XB_TOP      3328
#define XB_TOPGEN   3392
#define XCD_BAR_WORDS 3456
#define XB_SPIN_CAP (1u << 22)
__device__ __forceinline__ unsigned xb_ld(unsigned* p)              { return __hip_atomic_load(p, __ATOMIC_RELAXED, __HIP_MEMORY_SCOPE_AGENT); }
__device__ __forceinline__ unsigned xb_add(unsigned* p, unsigned v) { return __hip_atomic_fetch_add(p, v, __ATOMIC_RELAXED, __HIP_MEMORY_SCOPE_AGENT); }
__device__ __forceinline__ unsigned xb_xcc_id() { return (unsigned)__builtin_amdgcn_s_getreg((3 << 11) | 20) & 0xFu; }
#define XB_SPIN(cond, bar) do { unsigned _sp = 0; while (cond) { __builtin_amdgcn_s_sleep(1); \
    if ((++_sp & 255u) == 0u) { if (xb_ld(&(bar)[XB_TMO])) break; if (_sp > XB_SPIN_CAP) { atomicAdd(&(bar)[XB_TMO], 1u); break; } } } } while (0)
struct XcdBarrier { unsigned* bar; unsigned x; volatile LAS unsigned* st; };
__device__ __forceinline__ XcdBarrier xcd_barrier_post(unsigned* bar, volatile LAS unsigned* st) {
    XcdBarrier b; b.bar = bar; b.x = xb_xcc_id(); b.st = st;
    if (threadIdx.x == 0) (void)xb_add(&bar[XB_XCNT(b.x)], 1u);
    return b;
}
__device__ __forceinline__ void xcd_barrier_complete(unsigned* bar, unsigned x, unsigned& nloc, unsigned& nx) {
    const unsigned G = gridDim.x * gridDim.y * gridDim.z;
    unsigned sum, cnt, mine, sp = 0u;
    for (;;) {
        sum = 0u; cnt = 0u; mine = 0u;
#pragma unroll
        for (unsigned j = 0; j < 16; ++j) { const unsigned c = xb_ld(&bar[XB_XCNT(j)]); sum += c; cnt += (c > 0u) ? 1u : 0u; mine = (j == x) ? c : mine; }
        if (sum == G) break;
        __builtin_amdgcn_s_sleep(1);
        if ((++sp & 255u) == 0u) { if (xb_ld(&bar[XB_TMO])) break; if (sp > XB_SPIN_CAP) { atomicAdd(&bar[XB_TMO], 1u); break; } }
    }
    nloc = mine > 0u ? mine : 1u; nx = cnt > 0u ? cnt : 1u;
}
__device__ __forceinline__ void xcd_barrier(const XcdBarrier& b) {
    asm volatile("s_waitcnt vmcnt(0)" ::: "memory");
    __syncthreads();
    if (threadIdx.x == 0) {
        unsigned* bar = b.bar;
        __builtin_amdgcn_s_waitcnt(0);
        unsigned nloc = b.st[0], nx = b.st[1];
        if (nloc == 0u) { xcd_barrier_complete(bar, b.x, nloc, nx); b.st[0] = nloc; b.st[1] = nx; }
        const unsigned old = xb_add(&bar[XB_XSUB(b.x)], 1u);
        const unsigned gen = old / nloc;
        if (old + 1u == (gen + 1u) * nloc) {
            __builtin_amdgcn_fence(__ATOMIC_RELEASE, "agent");
            asm volatile("s_waitcnt vmcnt(0)" ::: "memory");
            const unsigned og = xb_add(&bar[XB_TOP], 1u);
            const unsigned tg = og / nx;
            if (og + 1u == (tg + 1u) * nx) xb_add(&bar[XB_TOPGEN], 1u);
            else XB_SPIN(xb_ld(&bar[XB_TOPGEN]) == tg, bar);
            __builtin_amdgcn_fence(__ATOMIC_ACQUIRE, "agent");
            xb_add(&bar[XB_XGEN(b.x)], 1u);
            asm volatile("s_waitcnt vmcnt(0)" ::: "memory");
        } else {
            XB_SPIN(xb_ld(&bar[XB_XGEN(b.x)]) == gen, bar);
            __builtin_amdgcn_fence(__ATOMIC_ACQUIRE, "agent");
            asm volatile("s_waitcnt vmcnt(0)" ::: "memory");
        }
    }
    __syncthreads();
}

namespace pg8 {
constexpr int BM = 256, BK = 64, HALF = 128, HTB = HALF * BK * 2, STAGE_BYTES = 8 * HTB, NXCD = 8, WGM = 8;
__host__ __device__ __forceinline__ int lds_byte(int r, int c) { const int st = (r >> 4) * 2 + (c >> 5), rr = r & 15, cc = c & 31, ob = rr * 64 + cc * 2; return st * 1024 + (ob ^ (((ob >> 9) & 1) << 5)); }
__host__ __device__ __forceinline__ void stage_rc(int b, int& R, int& C) { const int st = b / 1024, sb = b % 1024, swz = sb ^ (((sb >> 9) & 1) << 5); R = (st >> 1) * 16 + swz / 64; C = (st & 1) * 32 + (swz % 64) / 2; }
__host__ __device__ __forceinline__ int perm32(int rho) { const int n = rho >> 4, i = rho & 15; return 8 * (i >> 2) + 4 * n + (i & 3); }
struct Unit { int pm, pn; };
struct Gemm { const bf16_t* A; const bf16_t* Bt; int M, N, K; };
struct StaticOrder {
    int nM, nN, nwg, G, c;
    __device__ void init(int M, int N, int G_, int c_) { nM = M / BM; nN = N / BM; nwg = nM * nN; G = G_; c = c_; }
    __device__ bool next(int i, Unit& u) const {
        const long L = (long)i * G + c; if (L >= nwg) return false;
        int wgid = (int)L; { const int q = nwg / NXCD, r = nwg % NXCD, xcd = wgid % NXCD, off = wgid / NXCD; wgid = (xcd < r ? xcd * (q + 1) : r * (q + 1) + (xcd - r) * q) + off; }
        const int nig = WGM * nN, gid = wgid / nig, fm = gid * WGM, gsz = (nM - fm) < WGM ? (nM - fm) : WGM;
        u.pm = fm + ((wgid % nig) % gsz); u.pn = (wgid % nig) / gsz; return true;
    }
};

template <class Epi>
__device__ __forceinline__ void gemm_phase(LAS unsigned char* lds, const Gemm g, const StaticOrder& S, const Epi& E) {
    const int tid = otid(), wid = __builtin_amdgcn_readfirstlane(tid >> 6), lane = tid & 63, wr = wid >> 2, wc = wid & 3, fr = lane & 15, fq = lane >> 4;
    const int K = g.K, nt = K / BK;
    unsigned voffA[2], voffB[2];
#pragma unroll
    for (int i = 0; i < 2; ++i) { int R, C; stage_rc(tid * 16 + i * 8192, R, C); const int Rb = Epi::PERM ? ((R & ~31) + perm32(R & 31)) : R;
        voffA[i] = (unsigned)(R * K + C) * 2u; voffB[i] = (unsigned)(Rb * K + C) * 2u; }
    const size_t kstep = (size_t)(BK * 2);
    const size_t hstep = (size_t)HALF * K * 2;
    const size_t tstep = 2 * hstep;
    const unsigned ldsw = (unsigned)wid * 1024u;
    const int aoff = lds_byte(wr * 64 + fr, fq * 8), boff = lds_byte(wc * 32 + fr, fq * 8);
#define PG8_SA(b, h) (((b) * 2 + (h)) * HTB)
#define PG8_SB(b, h) ((4 + (b) * 2 + (h)) * HTB)
#define PG8_STAGE(bufoff, gbase, voff) do { _Pragma("unroll") for (int _i = 0; _i < 2; ++_i) \
        __builtin_amdgcn_global_load_lds((const unsigned*)((const char*)(gbase) + (voff)[_i]), (LAS unsigned*)(lds + (bufoff) + ldsw + _i * 8192), 16, 0, 0); } while (0)
#define PG8_LDA(dst, b, h) do { _Pragma("unroll") for (int m = 0; m < 4; ++m) _Pragma("unroll") for (int k = 0; k < 2; ++k) dst[m][k] = *(const LAS bf16x8*)(lds + PG8_SA(b, h) + aoff + m * 2048 + k * 1024); } while (0)
#define PG8_LDB(dst, b, h) do { _Pragma("unroll") for (int n = 0; n < 2; ++n) _Pragma("unroll") for (int k = 0; k < 2; ++k) dst[n][k] = *(const LAS bf16x8*)(lds + PG8_SB(b, h) + boff + n * 2048 + k * 1024); } while (0)
#define PG8_MMA(ai, bj, At, Bt) do { __builtin_amdgcn_s_setprio(1); _Pragma("unroll") for (int m = 0; m < 4; ++m) _Pragma("unroll") for (int n = 0; n < 2; ++n) _Pragma("unroll") for (int k = 0; k < 2; ++k) \
        acc[ai][bj][m][n] = __builtin_amdgcn_mfma_f32_16x16x32_bf16(Bt[n][k], At[m][k], acc[ai][bj][m][n], 0, 0, 0); __builtin_amdgcn_s_setprio(0); } while (0)
#define PG8_WAIT_V(n) asm volatile("s_waitcnt vmcnt(" #n ")" ::: "memory")
#define PG8_WAIT_L(n) asm volatile("s_waitcnt lgkmcnt(" #n ")" ::: "memory")
#define PG8_BAR __builtin_amdgcn_s_barrier()
#define PG8_SCHED __builtin_amdgcn_sched_barrier(0)
    Unit cur, nxt; int ui = 0;
    if (!S.next(0, cur)) return;
    f32x4 acc[2][2][4][2];
#pragma unroll
    for (int a = 0; a < 2; ++a)
#pragma unroll
        for (int b = 0; b < 2; ++b)
#pragma unroll
            for (int m = 0; m < 4; ++m)
#pragma unroll
                for (int n = 0; n < 2; ++n) acc[a][b][m][n] = (f32x4){0.f, 0.f, 0.f, 0.f};
    bf16x8 At[4][2], B0[2][2], B1[2][2];
    const char* cA = (const char*)g.A + (size_t)cur.pm * tstep; const char* cB = (const char*)g.Bt + (size_t)cur.pn * tstep;
    PG8_STAGE(PG8_SB(0, 0), cB, voffB); PG8_STAGE(PG8_SA(0, 0), cA, voffA); PG8_STAGE(PG8_SB(0, 1), cB + hstep, voffB); PG8_STAGE(PG8_SA(0, 1), cA + hstep, voffA);
    if (wr == 1) PG8_BAR;
    PG8_WAIT_V(4); PG8_BAR;
    PG8_STAGE(PG8_SB(1, 0), cB + kstep, voffB); PG8_STAGE(PG8_SA(1, 0), cA + kstep, voffA); PG8_STAGE(PG8_SB(1, 1), cB + hstep + kstep, voffB);
    PG8_WAIT_V(6); PG8_BAR;
    for (;;) {
        const bool has_next = S.next(ui + 1, nxt);
        const char* nA = has_next ? (const char*)g.A + (size_t)nxt.pm * tstep : cA; const char* nB = has_next ? (const char*)g.Bt + (size_t)nxt.pn * tstep : cB;
        for (int t = 0; t < nt; t += 2) {
            const bool last = (t == nt - 2);
            const char* a1 = cA + (size_t)(t + 1) * kstep;
            const char* a2 = last ? nA : cA + (size_t)(t + 2) * kstep; const char* b2 = last ? nB : cB + (size_t)(t + 2) * kstep;
            const char* a3 = a2 + kstep; const char* b3 = b2 + kstep;
            PG8_LDB(B0, 0, 0); PG8_SCHED; PG8_LDA(At, 0, 0); PG8_STAGE(PG8_SA(1, 1), a1 + hstep, voffA);
            PG8_WAIT_L(8); PG8_BAR; PG8_WAIT_L(0); PG8_MMA(0, 0, At, B0); PG8_BAR; PG8_SCHED;
            PG8_LDB(B1, 0, 1); PG8_STAGE(PG8_SB(0, 0), b2, voffB);
            PG8_BAR; PG8_WAIT_L(0); PG8_MMA(0, 1, At, B1); PG8_BAR;
            PG8_LDA(At, 0, 1); PG8_STAGE(PG8_SA(0, 0), a2, voffA);
            PG8_BAR; PG8_WAIT_L(0); PG8_MMA(1, 0, At, B0); PG8_BAR; PG8_SCHED;
            PG8_STAGE(PG8_SB(0, 1), b2 + hstep, voffB);
            PG8_WAIT_V(6); PG8_BAR; PG8_MMA(1, 1, At, B1); PG8_BAR;
            PG8_LDB(B0, 1, 0); PG8_SCHED; PG8_LDA(At, 1, 0); PG8_STAGE(PG8_SA(0, 1), a2 + hstep, voffA);
            PG8_WAIT_L(8); PG8_BAR; PG8_WAIT_L(0); PG8_MMA(0, 0, At, B0); PG8_BAR; PG8_SCHED;
            PG8_LDB(B1, 1, 1); PG8_STAGE(PG8_SB(1, 0), b3, voffB);
            PG8_BAR; PG8_WAIT_L(0); PG8_MMA(0, 1, At, B1); PG8_BAR;
            PG8_LDA(At, 1, 1); PG8_STAGE(PG8_SA(1, 0), a3, voffA);
            PG8_BAR; PG8_WAIT_L(0); PG8_MMA(1, 0, At, B0); PG8_BAR; PG8_SCHED;
            PG8_STAGE(PG8_SB(1, 1), b3 + hstep, voffB);
            PG8_WAIT_V(6); PG8_BAR; PG8_MMA(1, 1, At, B1); PG8_BAR;
        }
        E(acc, cur, wr, wc, fr, fq);
        if (!has_next) break;
#pragma unroll
        for (int a = 0; a < 2; ++a)
#pragma unroll
            for (int b = 0; b < 2; ++b)
#pragma unroll
                for (int m = 0; m < 4; ++m)
#pragma unroll
                    for (int n = 0; n < 2; ++n) acc[a][b][m][n] = (f32x4){0.f, 0.f, 0.f, 0.f};
        cur = nxt; cA = nA; cB = nB; ++ui;
    }
    PG8_WAIT_V(0);
    if (wr == 0) PG8_BAR;
    PG8_BAR;
#undef PG8_SA
#undef PG8_SB
#undef PG8_STAGE
#undef PG8_LDA
#undef PG8_LDB
#undef PG8_MMA
#undef PG8_WAIT_V
#undef PG8_WAIT_L
#undef PG8_BAR
#undef PG8_SCHED
}
}
using pg8::Unit;

__device__ __forceinline__ float silu_mul(float g, float u) { return g * u * __builtin_amdgcn_rcpf(1.0f + __expf(-g)); }

struct EpiSwiglu {
    static constexpr bool PERM = true;
    bf16_t* H;
    __device__ __forceinline__ void operator()(const f32x4 (&acc)[2][2][4][2], const Unit& u, int wr, int wc, int fr, int fq) const {
        const int row0 = u.pm * 256 + wr * 64 + fr, f0 = u.pn * 128 + wc * 32 + 8 * fq;
#pragma unroll
        for (int ai = 0; ai < 2; ++ai)
#pragma unroll
            for (int m = 0; m < 4; ++m) {
                const f32x4 g0 = acc[ai][0][m][0], g1 = acc[ai][0][m][1], u0 = acc[ai][1][m][0], u1 = acc[ai][1][m][1];
                u32x4 w;
                w.x = cvt_pk_bf16(silu_mul(g0[0], u0[0]), silu_mul(g0[1], u0[1])); w.y = cvt_pk_bf16(silu_mul(g0[2], u0[2]), silu_mul(g0[3], u0[3]));
                w.z = cvt_pk_bf16(silu_mul(g1[0], u1[0]), silu_mul(g1[1], u1[1])); w.w = cvt_pk_bf16(silu_mul(g1[2], u1[2]), silu_mul(g1[3], u1[3]));
                *(u32x4*)(H + (size_t)(row0 + ai * 128 + m * 16) * DFF + f0) = w;
            }
    }
};
struct EpiBf16 {
    static constexpr bool PERM = true;
    bf16_t* O; int ldc;
    __device__ __forceinline__ void operator()(const f32x4 (&acc)[2][2][4][2], const Unit& u, int wr, int wc, int fr, int fq) const {
        const int row0 = u.pm * 256 + wr * 64 + fr, col0 = u.pn * 256 + wc * 32 + 8 * fq;
#pragma unroll
        for (int ai = 0; ai < 2; ++ai)
#pragma unroll
            for (int m = 0; m < 4; ++m) { bf16_t* rowp = O + (size_t)(row0 + ai * 128 + m * 16) * ldc + col0;
#pragma unroll
                for (int bj = 0; bj < 2; ++bj) { const f32x4 v0 = acc[ai][bj][m][0], v1 = acc[ai][bj][m][1];
                    u32x4 w; w.x = cvt_pk_bf16(v0[0], v0[1]); w.y = cvt_pk_bf16(v0[2], v0[3]); w.z = cvt_pk_bf16(v1[0], v1[1]); w.w = cvt_pk_bf16(v1[2], v1[3]);
                    *(u32x4*)(rowp + bj * 128) = w; } }
    }
};
struct EpiRes {
    static constexpr bool PERM = false;
    const bf16_t* Y; float* Z; float scale;
    __device__ __forceinline__ void operator()(const f32x4 (&acc)[2][2][4][2], const Unit& u, int wr, int wc, int fr, int fq) const {
        const int row0 = u.pm * 256 + wr * 64 + fr, col0 = u.pn * 256 + wc * 32 + 4 * fq;
#pragma unroll
        for (int ai = 0; ai < 2; ++ai)
#pragma unroll
            for (int m = 0; m < 4; ++m) { const size_t off = (size_t)(row0 + ai * 128 + m * 16) * 1024 + col0;
#pragma unroll
                for (int bj = 0; bj < 2; ++bj)
#pragma unroll
                    for (int n = 0; n < 2; ++n) { const size_t o = off + bj * 128 + n * 16; const u32x2 yv = *(const u32x2*)(Y + o); const f32x4 a = acc[ai][bj][m][n];
                        f32x4 z; z[0] = ALPHA * bflo(yv.x) + scale * a[0]; z[1] = ALPHA * bfhi(yv.x) + scale * a[1]; z[2] = ALPHA * bflo(yv.y) + scale * a[2]; z[3] = ALPHA * bfhi(yv.y) + scale * a[3];
                        *(f32x4*)(Z + o) = z; } }
    }
};
struct EpiMemKV {
    static constexpr bool PERM = false;
    float* out; bf16_t* MK; bf16_t* VT;
    __device__ __forceinline__ void operator()(const f32x4 (&acc)[2][2][4][2], const Unit& u, int wr, int wc, int fr, int fq) const {
        const int which = u.pn >> 2, l = which >> 1, isv = which & 1, h = u.pn & 3;
        float* ob = out + (isv ? OUT_MVP : OUT_MKP) + (size_t)l * 524288;
#pragma unroll
        for (int ai = 0; ai < 2; ++ai)
#pragma unroll
            for (int m = 0; m < 4; ++m) { const int row = u.pm * 256 + ai * 128 + wr * 64 + m * 16 + fr;
#pragma unroll
                for (int bj = 0; bj < 2; ++bj)
#pragma unroll
                    for (int n = 0; n < 2; ++n) { const int dim = bj * 128 + wc * 32 + n * 16 + 4 * fq; const f32x4 a = acc[ai][bj][m][n];
                        *(f32x4*)(ob + (size_t)row * 1024 + h * 256 + dim) = a;
                        if (!isv) { u32x2 w; w.x = cvt_pk_bf16(a[0], a[1]); w.y = cvt_pk_bf16(a[2], a[3]); *(u32x2*)(MK + (size_t)l * 524288 + (size_t)row * 1024 + h * 256 + dim) = w; }
                        else { bf16_t* vt = VT + ((size_t)((l * 2 + (row >> 8)) * 4 + h)) * 65536 + (size_t)dim * 256 + (row & 255);
                            vt[0] = f2bf(a[0]); vt[256] = f2bf(a[1]); vt[512] = f2bf(a[2]); vt[768] = f2bf(a[3]); } } }
    }
};

template <int MODE>
__device__ __forceinline__ void sample_gemm(LAS unsigned char* lds, const bf16_t* A, int K, const bf16_t* Bt, int N, bf16_t* O, int ldc, const bf16_t* Y, float* Z, float scale) {
    const int tid = otid(), wid = tid >> 6, lane = tid & 63;
    const int nitems = 8 * (MODE == 1 ? DFF / 16 : N / 32);
    const int kw = K >> 3, nks = kw >> 5, k0 = wid * kw;
    LAS f32x4* red = (LAS f32x4*)lds;
    for (int it = obid(); it < nitems; it += ogrid()) {
        const int rg = it & 7, cgp = it >> 3, row0 = rg * 16;
        int brow0, brow1;
        if (MODE == 1) { const int f0 = cgp * 16, t = f0 >> 7, r = f0 & 127; brow0 = 256 * t + r; brow1 = brow0 + 128; }
        else { brow0 = cgp * 32; brow1 = brow0 + 16; }
        const bf16_t* ap = A + (size_t)(row0 + (lane & 15)) * K + k0 + 8 * (lane >> 4);
        const bf16_t* b0p = Bt + (size_t)(brow0 + (lane & 15)) * K + k0 + 8 * (lane >> 4);
        const bf16_t* b1p = Bt + (size_t)(brow1 + (lane & 15)) * K + k0 + 8 * (lane >> 4);
        f32x4 c0 = {0.f, 0.f, 0.f, 0.f}, c1 = {0.f, 0.f, 0.f, 0.f};
#pragma unroll 4
        for (int s = 0; s < nks; ++s) {
            const bf16x8 a = *(const bf16x8*)(ap + 32 * s), b0 = *(const bf16x8*)(b0p + 32 * s), b1 = *(const bf16x8*)(b1p + 32 * s);
            c0 = __builtin_amdgcn_mfma_f32_16x16x32_bf16(b0, a, c0, 0, 0, 0);
            c1 = __builtin_amdgcn_mfma_f32_16x16x32_bf16(b1, a, c1, 0, 0, 0);
        }
        red[(wid * 2 + 0) * 64 + lane] = c0; red[(wid * 2 + 1) * 64 + lane] = c1;
        __syncthreads();
        if (MODE == 1) {
            if (tid < 64) {
                f32x4 g = {0.f, 0.f, 0.f, 0.f}, u = {0.f, 0.f, 0.f, 0.f};
#pragma unroll
                for (int w = 0; w < 8; ++w) { g += red[(w * 2 + 0) * 64 + tid]; u += red[(w * 2 + 1) * 64 + tid]; }
                const int m = tid & 15, n4 = 4 * (tid >> 4);
                u32x2 w2; w2.x = cvt_pk_bf16(silu_mul(g[0], u[0]), silu_mul(g[1], u[1])); w2.y = cvt_pk_bf16(silu_mul(g[2], u[2]), silu_mul(g[3], u[3]));
                *(u32x2*)(O + (size_t)(row0 + m) * DFF + cgp * 16 + n4) = w2;
            }
        } else {
            if (tid < 128) {
                const int ct = tid >> 6, ln = tid & 63;
                f32x4 v = {0.f, 0.f, 0.f, 0.f};
#pragma unroll
                for (int w = 0; w < 8; ++w) v += red[(w * 2 + ct) * 64 + ln];
                const int m = ln & 15, col = cgp * 32 + ct * 16 + 4 * (ln >> 4);
                if (MODE == 0) { u32x2 w2; w2.x = cvt_pk_bf16(v[0], v[1]); w2.y = cvt_pk_bf16(v[2], v[3]); *(u32x2*)(O + (size_t)(row0 + m) * ldc + col) = w2; }
                else { const size_t o = (size_t)(row0 + m) * 1024 + col; const u32x2 yv = *(const u32x2*)(Y + o);
                    f32x4 z; z[0] = ALPHA * bflo(yv.x) + scale * v[0]; z[1] = ALPHA * bfhi(yv.x) + scale * v[1]; z[2] = ALPHA * bflo(yv.y) + scale * v[2]; z[3] = ALPHA * bfhi(yv.y) + scale * v[3];
                    *(f32x4*)(Z + o) = z; }
            }
        }
        __syncthreads();
    }
}

__device__ __forceinline__ void ln_phase(const float* Z, bf16_t* Y, const float* g, const float* b, float* outf) {
    const int tid = otid(), wid = tid >> 6, lane = tid & 63;
    f32x4 g4[4], b4[4];
#pragma unroll
    for (int j = 0; j < 4; ++j) { g4[j] = *(const f32x4*)(g + 256 * j + 4 * lane); b4[j] = *(const f32x4*)(b + 256 * j + 4 * lane); }
    for (int row = obid() * 8 + wid; row < MT; row += ogrid() * 8) {
        f32x4 v[4]; float s = 0.f;
#pragma unroll
        for (int j = 0; j < 4; ++j) { v[j] = *(const f32x4*)(Z + (size_t)row * 1024 + 256 * j + 4 * lane); s += (v[j][0] + v[j][1]) + (v[j][2] + v[j][3]); }
        const float mean = wave_sum(s) * (1.0f / 1024.0f);
        float q = 0.f;
#pragma unroll
        for (int j = 0; j < 4; ++j) { v[j] -= mean; q += (v[j][0] * v[j][0] + v[j][1] * v[j][1]) + (v[j][2] * v[j][2] + v[j][3] * v[j][3]); }
        const float rstd = rsqrtf(wave_sum(q) * (1.0f / 1024.0f) + LN_EPS);
#pragma unroll
        for (int j = 0; j < 4; ++j) { const f32x4 y = v[j] * rstd * g4[j] + b4[j];
            if (outf) *(f32x4*)(outf + (size_t)row * 1024 + 256 * j + 4 * lane) = y;
            u32x2 w; w.x = cvt_pk_bf16(y[0], y[1]); w.y = cvt_pk_bf16(y[2], y[3]); *(u32x2*)(Y + (size_t)row * 1024 + 256 * j + 4 * lane) = w; }
    }
}

__device__ __forceinline__ void tr_job(LAS unsigned char* lds, const float* src, int Nsrc, int K, bf16_t* dst, int Ndst, bool gu) {
    LAS float* t = (LAS float*)lds;
    const int tid = otid(), nkt = K >> 6, ntiles = nkt * (Ndst >> 6);
    for (int tile = obid(); tile < ntiles; tile += ogrid()) {
        const int tk = tile % nkt, tn = tile / nkt, n0 = tn * 64, k0 = tk * 64;
        int sc0 = n0;
        if (gu) { const int tt = n0 >> 8, r = n0 & 255; sc0 = (r < 128) ? 128 * tt + r : DFF + 128 * tt + (r - 128); }
#pragma unroll
        for (int j = 0; j < 2; ++j) { const int kr = (tid >> 4) + 32 * j, c = (tid & 15) * 4;
            const f32x4 v = *(const f32x4*)(src + (size_t)(k0 + kr) * Nsrc + sc0 + c);
            t[kr * 65 + c] = v[0]; t[kr * 65 + c + 1] = v[1]; t[kr * 65 + c + 2] = v[2]; t[kr * 65 + c + 3] = v[3]; }
        __syncthreads();
        { const int n = tid >> 3, kk = (tid & 7) * 8; u32x4 w;
            w.x = cvt_pk_bf16(t[(kk + 0) * 65 + n], t[(kk + 1) * 65 + n]); w.y = cvt_pk_bf16(t[(kk + 2) * 65 + n], t[(kk + 3) * 65 + n]);
            w.z = cvt_pk_bf16(t[(kk + 4) * 65 + n], t[(kk + 5) * 65 + n]); w.w = cvt_pk_bf16(t[(kk + 6) * 65 + n], t[(kk + 7) * 65 + n]);
            *(u32x4*)(dst + (size_t)(n0 + n) * K + k0 + kk) = w; }
        __syncthreads();
    }
}
__device__ __forceinline__ void cvt_job(const float* src, bf16_t* dst, size_t n) {
    for (size_t i = ((size_t)obid() * 512 + otid()) * 8; i < n; i += (size_t)ogrid() * 512 * 8) {
        const f32x4 a = *(const f32x4*)(src + i), b = *(const f32x4*)(src + i + 4);
        u32x4 w; w.x = cvt_pk_bf16(a[0], a[1]); w.y = cvt_pk_bf16(a[2], a[3]); w.z = cvt_pk_bf16(b[0], b[1]); w.w = cvt_pk_bf16(b[2], b[3]);
        *(u32x4*)(dst + i) = w;
    }
}

constexpr int KS_STRIDE = 72, VT_STRIDE = 264, KS_BYTES = 256 * KS_STRIDE * 2;

__device__ __forceinline__ void mixer_prompt(LAS unsigned char* lds, int l, const bf16_t* P, bf16_t* ZM, const float* convw, const float* sinks, float* out) {
    const int tid = otid(), wid = tid >> 6, lane = tid & 63, r = lane & 31, hh = lane >> 5;
    LAS bf16_t* VTs = (LAS bf16_t*)(lds + KS_BYTES);
    for (int item = obid(); item < 256; item += ogrid()) {
        const int b = item >> 7, blk = (item & 127) >> 1, kvh = item & 1;
        const int rowk0 = b * SEQ + (blk - 1) * 128;
        __syncthreads();
#pragma unroll
        for (int j = 0; j < 4; ++j) {
            const int c = tid + 512 * j, key = c >> 3, part = c & 7;
            const bool valid = (blk > 0) || (key >= 128);
            u32x4 kv = {0u, 0u, 0u, 0u}, vv = {0u, 0u, 0u, 0u};
            if (valid) { const bf16_t* pr = P + (size_t)(rowk0 + key) * INC + 2048 + kvh * 64 + part * 8; kv = *(const u32x4*)pr; vv = *(const u32x4*)(pr + 128); }
            *(LAS u32x4*)(lds + (key * KS_STRIDE + part * 8) * 2) = kv;
            LAS bf16_t* vp = VTs + (part * 8) * VT_STRIDE + key;
            vp[0 * VT_STRIDE] = (bf16_t)(vv.x & 0xffff); vp[1 * VT_STRIDE] = (bf16_t)(vv.x >> 16); vp[2 * VT_STRIDE] = (bf16_t)(vv.y & 0xffff); vp[3 * VT_STRIDE] = (bf16_t)(vv.y >> 16);
            vp[4 * VT_STRIDE] = (bf16_t)(vv.z & 0xffff); vp[5 * VT_STRIDE] = (bf16_t)(vv.z >> 16); vp[6 * VT_STRIDE] = (bf16_t)(vv.w & 0xffff); vp[7 * VT_STRIDE] = (bf16_t)(vv.w >> 16);
            if (blk == 63 && key >= 128) {
                const size_t o = ((((size_t)l * 2 + b) * 128 + (key - 128)) * 2 + kvh) * 64 + part * 8;
                f32x4 k0v = {bflo(kv.x), bfhi(kv.x), bflo(kv.y), bfhi(kv.y)}, k1v = {bflo(kv.z), bfhi(kv.z), bflo(kv.w), bfhi(kv.w)};
                f32x4 v0v = {bflo(vv.x), bfhi(vv.x), bflo(vv.y), bfhi(vv.y)}, v1v = {bflo(vv.z), bfhi(vv.z), bflo(vv.w), bfhi(vv.w)};
                *(f32x4*)(out + OUT_WKP + o) = k0v; *(f32x4*)(out + OUT_WKP + o + 4) = k1v;
                *(f32x4*)(out + OUT_WVP + o) = v0v; *(f32x4*)(out + OUT_WVP + o + 4) = v1v;
            }
        }
        __syncthreads();
#pragma unroll 1
        for (int wi2 = 0; wi2 < 2; ++wi2) {
            const int wi = wid * 2 + wi2, hq = wi >> 2, rt = wi & 3, a0 = rt * 32, qh = kvh * 4 + hq;
            const int qrow = b * SEQ + blk * 128 + a0 + r;
            bf16x8 qf[4];
#pragma unroll
            for (int s = 0; s < 4; ++s) qf[s] = *(const bf16x8*)(P + (size_t)qrow * INC + 1536 + qh * 64 + 16 * s + 8 * hh);
            f32x16 S[5];
#pragma unroll
            for (int kt5 = 0; kt5 < 5; ++kt5) {
#pragma unroll
                for (int e = 0; e < 16; ++e) S[kt5][e] = 0.f;
#pragma unroll
                for (int s = 0; s < 4; ++s) {
                    const bf16x8 kf = *(const LAS bf16x8*)(lds + (((rt + kt5) * 32 + r) * KS_STRIDE + 16 * s + 8 * hh) * 2);
                    S[kt5] = __builtin_amdgcn_mfma_f32_32x32x16_bf16(kf, qf[s], S[kt5], 0, 0, 0);
                }
            }
            const float sink = sinks[l * 8 + qh];
            float mx = -INFINITY;
            const int a = a0 + r;
#pragma unroll
            for (int kt5 = 0; kt5 < 5; ++kt5)
#pragma unroll
                for (int e = 0; e < 16; ++e) {
                    const int c = (rt + kt5) * 32 + (e & 3) + 8 * (e >> 2) + 4 * hh, rel = 128 + a - c;
                    const bool valid = (rel >= 0) && (rel <= 128) && ((blk > 0) || (c >= 128));
                    const float sv = valid ? S[kt5][e] * 0.125f : -INFINITY;
                    S[kt5][e] = sv; mx = fmaxf(mx, sv);
                }
            mx = fmaxf(mx, __shfl_xor(mx, 32));
            const float mm = fmaxf(mx, sink);
            float sum = 0.f;
#pragma unroll
            for (int kt5 = 0; kt5 < 5; ++kt5)
#pragma unroll
                for (int e = 0; e < 16; ++e) { const float pv = __expf(S[kt5][e] - mm); S[kt5][e] = pv; sum += pv; }
            sum += __shfl_xor(sum, 32);
            const float inv = 1.0f / (sum + __expf(sink - mm));
            f32x16 O[2];
#pragma unroll
            for (int mt = 0; mt < 2; ++mt)
#pragma unroll
                for (int e = 0; e < 16; ++e) O[mt][e] = 0.f;
#pragma unroll
            for (int kt5 = 0; kt5 < 5; ++kt5)
#pragma unroll
                for (int s2 = 0; s2 < 2; ++s2) {
                    u32x4 pw; pw.x = cvt_pk_bf16(S[kt5][8 * s2 + 0], S[kt5][8 * s2 + 1]); pw.y = cvt_pk_bf16(S[kt5][8 * s2 + 2], S[kt5][8 * s2 + 3]);
                    pw.z = cvt_pk_bf16(S[kt5][8 * s2 + 4], S[kt5][8 * s2 + 5]); pw.w = cvt_pk_bf16(S[kt5][8 * s2 + 6], S[kt5][8 * s2 + 7]);
                    const bf16x8 pf = __builtin_bit_cast(bf16x8, pw);
                    const int keybase = (rt + kt5) * 32 + 16 * s2 + 4 * hh;
#pragma unroll
                    for (int mt = 0; mt < 2; ++mt) {
                        const LAS bf16_t* vp = VTs + (mt * 32 + r) * VT_STRIDE + keybase;
                        const u32x2 lo = *(const LAS u32x2*)vp, hi = *(const LAS u32x2*)(vp + 8);
                        u32x4 vw; vw.x = lo.x; vw.y = lo.y; vw.z = hi.x; vw.w = hi.y;
                        O[mt] = __builtin_amdgcn_mfma_f32_32x32x16_bf16(__builtin_bit_cast(bf16x8, vw), pf, O[mt], 0, 0, 0);
                    }
                }
#pragma unroll
            for (int mt = 0; mt < 2; ++mt)
#pragma unroll
                for (int gq = 0; gq < 4; ++gq) {
                    u32x2 w; w.x = cvt_pk_bf16(O[mt][4 * gq + 0] * inv, O[mt][4 * gq + 1] * inv); w.y = cvt_pk_bf16(O[mt][4 * gq + 2] * inv, O[mt][4 * gq + 3] * inv);
                    *(u32x2*)(ZM + (size_t)qrow * 1024 + 512 + qh * 64 + mt * 32 + 8 * gq + 4 * hh) = w;
                }
        }
        {
            const int ch0 = kvh * 256 + (tid & 31) * 8, rgp = tid >> 5, p0 = blk * 128 + rgp * 8;
            float w0[8], w1[8], w2[8], u1[8], u2[8];
#pragma unroll
            for (int e = 0; e < 8; ++e) { w0[e] = convw[(l * 3 + 0) * 512 + ch0 + e]; w1[e] = convw[(l * 3 + 1) * 512 + ch0 + e]; w2[e] = convw[(l * 3 + 2) * 512 + ch0 + e]; u1[e] = 0.f; u2[e] = 0.f; }
#pragma unroll
            for (int i = -2; i < 8; ++i) {
                const int pos = p0 + i;
                float uu[8];
#pragma unroll
                for (int e = 0; e < 8; ++e) uu[e] = 0.f;
                const bf16_t* pr = P + (size_t)(b * SEQ + pos) * INC + ch0;
                if (pos >= 0) {
                    const u32x4 cgv = *(const u32x4*)(pr + 512), hcv = *(const u32x4*)(pr + 1024);
                    uu[0] = bflo(cgv.x) * bflo(hcv.x); uu[1] = bfhi(cgv.x) * bfhi(hcv.x); uu[2] = bflo(cgv.y) * bflo(hcv.y); uu[3] = bfhi(cgv.y) * bfhi(hcv.y);
                    uu[4] = bflo(cgv.z) * bflo(hcv.z); uu[5] = bfhi(cgv.z) * bfhi(hcv.z); uu[6] = bflo(cgv.w) * bflo(hcv.w); uu[7] = bfhi(cgv.w) * bfhi(hcv.w);
                }
                if (i >= 0) {
                    const u32x4 bgv = *(const u32x4*)pr;
                    float bg[8] = {bflo(bgv.x), bfhi(bgv.x), bflo(bgv.y), bfhi(bgv.y), bflo(bgv.z), bfhi(bgv.z), bflo(bgv.w), bfhi(bgv.w)};
                    float z[8];
#pragma unroll
                    for (int e = 0; e < 8; ++e) z[e] = bg[e] * (w0[e] * u2[e] + w1[e] * u1[e] + w2[e] * uu[e]);
                    u32x4 w; w.x = cvt_pk_bf16(z[0], z[1]); w.y = cvt_pk_bf16(z[2], z[3]); w.z = cvt_pk_bf16(z[4], z[5]); w.w = cvt_pk_bf16(z[6], z[7]);
                    *(u32x4*)(ZM + (size_t)(b * SEQ + pos) * 1024 + ch0) = w;
                    if (blk == 63 && rgp == 15 && i >= 6) {
                        float* oc = out + OUT_CVP + (((size_t)l * 2 + b) * 2 + (i - 6)) * 512 + ch0;
                        f32x4 o0 = {uu[0], uu[1], uu[2], uu[3]}, o1 = {uu[4], uu[5], uu[6], uu[7]};
                        *(f32x4*)oc = o0; *(f32x4*)(oc + 4) = o1;
                    }
                }
#pragma unroll
                for (int e = 0; e < 8; ++e) { u2[e] = u1[e]; u1[e] = uu[e]; }
            }
        }
    }
}

__device__ __forceinline__ void mixer_sample(LAS unsigned char* lds, int l, const bf16_t* P, bf16_t* ZM, const float* convw, const float* sinks, const float* cwk, const float* cwv, const float* sconv, float* out) {
    const int tid = otid(), wid = tid >> 6, lane = tid & 63;
    LAS float* Kc = (LAS float*)lds;
    LAS float* Vc = (LAS float*)(lds + 33792);
    LAS float* SC = (LAS float*)(lds + 67584);
    LAS float* QS = (LAS float*)(lds + 69888);
    for (int item = obid(); item < 256; item += ogrid()) {
        const int bs = item >> 1, kvh = item & 1;
        const bf16_t* pr = P + (size_t)(TP + bs) * INC;
        __syncthreads();
#pragma unroll
        for (int j = 0; j < 4; ++j) {
            const int c = tid + 512 * j, key = c >> 4, part = c & 15;
            const size_t src = ((((size_t)l * 128 + bs) * 128 + key) * 2 + kvh) * 64 + part * 4;
            const f32x4 kv = *(const f32x4*)(cwk + src), vv = *(const f32x4*)(cwv + src);
#pragma unroll
            for (int e = 0; e < 4; ++e) { Kc[key * 65 + part * 4 + e] = kv[e]; Vc[key * 65 + part * 4 + e] = vv[e]; }
            if (key >= 1) { const size_t o = ((((size_t)l * 128 + bs) * 128 + (key - 1)) * 2 + kvh) * 64 + part * 4;
                *(f32x4*)(out + OUT_WKS + o) = kv; *(f32x4*)(out + OUT_WVS + o) = vv; }
        }
        if (tid < 128) {
            const int d = tid & 63, isv = tid >> 6;
            const float x = bf2f(pr[2048 + isv * 128 + kvh * 64 + d]);
            (isv ? Vc : Kc)[128 * 65 + d] = x;
            out[(isv ? OUT_WVS : OUT_WKS) + ((((size_t)l * 128 + bs) * 128 + 127) * 2 + kvh) * 64 + d] = x;
        } else if (tid < 384) {
            const int i = tid - 128;
            QS[i] = bf2f(pr[1536 + kvh * 256 + i]);
        }
        __syncthreads();
        for (int idx = tid; idx < 4 * 129; idx += 512) {
            const int hq = idx / 129, key = idx - hq * 129;
            float s = 0.f;
#pragma unroll 16
            for (int d = 0; d < 64; ++d) s += QS[hq * 64 + d] * Kc[key * 65 + d];
            SC[hq * 132 + key] = s * 0.125f;
        }
        __syncthreads();
        if (wid < 4) {
            const float sink = sinks[l * 8 + kvh * 4 + wid];
            const float s0 = SC[wid * 132 + lane], s1 = SC[wid * 132 + 64 + lane], s2 = (lane == 0) ? SC[wid * 132 + 128] : -INFINITY;
            const float mm = fmaxf(wave_max(fmaxf(fmaxf(s0, s1), s2)), sink);
            const float p0 = __expf(s0 - mm), p1 = __expf(s1 - mm), p2 = __expf(s2 - mm);
            const float inv = 1.0f / (wave_sum(p0 + p1 + p2) + __expf(sink - mm));
            SC[wid * 132 + lane] = p0 * inv; SC[wid * 132 + 64 + lane] = p1 * inv; if (lane == 0) SC[wid * 132 + 128] = p2 * inv;
        }
        __syncthreads();
        if (tid < 256) {
            const int hq = tid >> 6, d = tid & 63;
            float o = 0.f;
#pragma unroll 8
            for (int key = 0; key < 129; ++key) o += SC[hq * 132 + key] * Vc[key * 65 + d];
            ZM[(size_t)(TP + bs) * 1024 + 512 + (kvh * 4 + hq) * 64 + d] = f2bf(o);
        } else {
            const int c = kvh * 256 + (tid - 256);
            const float bg = bf2f(pr[c]), u = bf2f(pr[512 + c]) * bf2f(pr[1024 + c]);
            const float s0 = sconv[(((size_t)l * 128 + bs) * 2 + 0) * 512 + c], s1 = sconv[(((size_t)l * 128 + bs) * 2 + 1) * 512 + c];
            const float z = bg * (convw[(l * 3 + 0) * 512 + c] * s0 + convw[(l * 3 + 1) * 512 + c] * s1 + convw[(l * 3 + 2) * 512 + c] * u);
            ZM[(size_t)(TP + bs) * 1024 + c] = f2bf(z);
            out[OUT_CVS + (((size_t)l * 128 + bs) * 2 + 0) * 512 + c] = s1;
            out[OUT_CVS + (((size_t)l * 128 + bs) * 2 + 1) * 512 + c] = u;
        }
    }
}

__device__ __forceinline__ void cross_prompt(LAS unsigned char* lds, int l, const bf16_t* Q, const bf16_t* MK, const bf16_t* VT, bf16_t* O) {
    const int tid = otid(), wid = tid >> 6, lane = tid & 63, r = lane & 31, hh = lane >> 5;
    LAS bf16_t* VTs = (LAS bf16_t*)(lds + KS_BYTES);
    for (int item = obid(); item < 256; item += ogrid()) {
        const int b = item >> 7, qt = (item & 127) >> 2, h = item & 3;
        const int qrow = b * SEQ + qt * 256 + wid * 32 + r;
        const bf16_t* mk = MK + (size_t)l * 524288 + (size_t)(b * 256) * 1024 + h * 256;
        const bf16_t* vt = VT + ((size_t)((l * 2 + b) * 4 + h)) * 65536;
        f32x16 S[8];
#pragma unroll
        for (int kt = 0; kt < 8; ++kt)
#pragma unroll
            for (int e = 0; e < 16; ++e) S[kt][e] = 0.f;
#pragma unroll 1
        for (int ch = 0; ch < 4; ++ch) {
            __syncthreads();
#pragma unroll
            for (int j = 0; j < 4; ++j) { const int c = tid + 512 * j, key = c >> 3, part = c & 7;
                *(LAS u32x4*)(lds + (key * KS_STRIDE + part * 8) * 2) = *(const u32x4*)(mk + (size_t)key * 1024 + ch * 64 + part * 8); }
            bf16x8 qf[4];
#pragma unroll
            for (int s = 0; s < 4; ++s) qf[s] = *(const bf16x8*)(Q + (size_t)qrow * 1024 + h * 256 + ch * 64 + 16 * s + 8 * hh);
            __syncthreads();
#pragma unroll
            for (int kt = 0; kt < 8; ++kt)
#pragma unroll
                for (int s = 0; s < 4; ++s) {
                    const bf16x8 kf = *(const LAS bf16x8*)(lds + ((kt * 32 + r) * KS_STRIDE + 16 * s + 8 * hh) * 2);
                    S[kt] = __builtin_amdgcn_mfma_f32_32x32x16_bf16(kf, qf[s], S[kt], 0, 0, 0);
                }
        }
        float mx = -INFINITY;
#pragma unroll
        for (int kt = 0; kt < 8; ++kt)
#pragma unroll
            for (int e = 0; e < 16; ++e) mx = fmaxf(mx, S[kt][e]);
        mx = fmaxf(mx, __shfl_xor(mx, 32));
        float sum = 0.f;
        bf16x8 pf[8][2];
#pragma unroll
        for (int kt = 0; kt < 8; ++kt) {
#pragma unroll
            for (int e = 0; e < 16; ++e) { const float pv = __expf((S[kt][e] - mx) * 0.0625f); S[kt][e] = pv; sum += pv; }
#pragma unroll
            for (int s2 = 0; s2 < 2; ++s2) {
                u32x4 pw; pw.x = cvt_pk_bf16(S[kt][8 * s2 + 0], S[kt][8 * s2 + 1]); pw.y = cvt_pk_bf16(S[kt][8 * s2 + 2], S[kt][8 * s2 + 3]);
                pw.z = cvt_pk_bf16(S[kt][8 * s2 + 4], S[kt][8 * s2 + 5]); pw.w = cvt_pk_bf16(S[kt][8 * s2 + 6], S[kt][8 * s2 + 7]);
                pf[kt][s2] = __builtin_bit_cast(bf16x8, pw);
            }
        }
        sum += __shfl_xor(sum, 32);
        const float inv = 1.0f / sum;
#pragma unroll 1
        for (int ch = 0; ch < 4; ++ch) {
            __syncthreads();
#pragma unroll
            for (int j = 0; j < 4; ++j) { const int c = tid + 512 * j, dim = c >> 5, part = c & 31;
                *(LAS u32x4*)(lds + KS_BYTES + (dim * VT_STRIDE + part * 8) * 2) = *(const u32x4*)(vt + (size_t)(ch * 64 + dim) * 256 + part * 8); }
            __syncthreads();
            f32x16 Oa[2];
#pragma unroll
            for (int mt = 0; mt < 2; ++mt)
#pragma unroll
                for (int e = 0; e < 16; ++e) Oa[mt][e] = 0.f;
#pragma unroll
            for (int kt = 0; kt < 8; ++kt)
#pragma unroll
                for (int s2 = 0; s2 < 2; ++s2)
#pragma unroll
                    for (int mt = 0; mt < 2; ++mt) {
                        const LAS bf16_t* vp = VTs + (mt * 32 + r) * VT_STRIDE + kt * 32 + 16 * s2 + 4 * hh;
                        const u32x2 lo = *(const LAS u32x2*)vp, hi = *(const LAS u32x2*)(vp + 8);
                        u32x4 vw; vw.x = lo.x; vw.y = lo.y; vw.z = hi.x; vw.w = hi.y;
                        Oa[mt] = __builtin_amdgcn_mfma_f32_32x32x16_bf16(__builtin_bit_cast(bf16x8, vw), pf[kt][s2], Oa[mt], 0, 0, 0);
                    }
#pragma unroll
            for (int mt = 0; mt < 2; ++mt)
#pragma unroll
                for (int gq = 0; gq < 4; ++gq) {
                    u32x2 w; w.x = cvt_pk_bf16(Oa[mt][4 * gq + 0] * inv, Oa[mt][4 * gq + 1] * inv); w.y = cvt_pk_bf16(Oa[mt][4 * gq + 2] * inv, Oa[mt][4 * gq + 3] * inv);
                    *(u32x2*)(O + (size_t)qrow * 1024 + h * 256 + ch * 64 + mt * 32 + 8 * gq + 4 * hh) = w;
                }
        }
    }
}

__device__ __forceinline__ void cross_sample(LAS unsigned char* lds, int l, const bf16_t* Q, const float* cmk, const float* cmv, bf16_t* O) {
    const int tid = otid(), wid = tid >> 6, lane = tid & 63;
    LAS float* SC = (LAS float*)lds;
    LAS f32x4* RED = (LAS f32x4*)(lds + 1024);
    for (int item = obid(); item < 512; item += ogrid()) {
        const int bs = item >> 2, h = item & 3;
        const u32x2 qw = *(const u32x2*)(Q + (size_t)(TP + bs) * 1024 + h * 256 + 4 * lane);
        const f32x4 qv = {bflo(qw.x), bfhi(qw.x), bflo(qw.y), bfhi(qw.y)};
        const float* kb = cmk + (((size_t)l * 128 + bs) * 256) * 1024 + h * 256 + 4 * lane;
        const float* vb = cmv + (((size_t)l * 128 + bs) * 256) * 1024 + h * 256 + 4 * lane;
        __syncthreads();
        float mys = 0.f;
#pragma unroll 1
        for (int kk = 0; kk < 32; kk += 8) {
            f32x4 kv[8];
#pragma unroll
            for (int i = 0; i < 8; ++i) kv[i] = *(const f32x4*)(kb + (size_t)(wid * 32 + kk + i) * 1024);
#pragma unroll
            for (int i = 0; i < 8; ++i) {
                const float d = wave_sum((kv[i][0] * qv[0] + kv[i][1] * qv[1]) + (kv[i][2] * qv[2] + kv[i][3] * qv[3]));
                if (lane == kk + i) mys = d;
            }
        }
        if (lane < 32) SC[wid * 32 + lane] = mys * 0.0625f;
        __syncthreads();
        const float s0 = SC[lane], s1 = SC[lane + 64], s2 = SC[lane + 128], s3 = SC[lane + 192];
        const float mx = wave_max(fmaxf(fmaxf(s0, s1), fmaxf(s2, s3)));
        const float inv = 1.0f / wave_sum((__expf(s0 - mx) + __expf(s1 - mx)) + (__expf(s2 - mx) + __expf(s3 - mx)));
        f32x4 acc = {0.f, 0.f, 0.f, 0.f};
#pragma unroll 1
        for (int kk = 0; kk < 32; kk += 8) {
            f32x4 vv[8];
#pragma unroll
            for (int i = 0; i < 8; ++i) vv[i] = *(const f32x4*)(vb + (size_t)(wid * 32 + kk + i) * 1024);
#pragma unroll
            for (int i = 0; i < 8; ++i) { const float pv = __expf(SC[wid * 32 + kk + i] - mx); acc += vv[i] * pv; }
        }
        RED[wid * 64 + lane] = acc;
        __syncthreads();
        if (tid < 64) {
            f32x4 o = {0.f, 0.f, 0.f, 0.f};
#pragma unroll
            for (int w = 0; w < 8; ++w) o += RED[w * 64 + tid];
            u32x2 w2; w2.x = cvt_pk_bf16(o[0] * inv, o[1] * inv); w2.y = cvt_pk_bf16(o[2] * inv, o[3] * inv);
            *(u32x2*)(O + (size_t)(TP + bs) * 1024 + h * 256 + 4 * tid) = w2;
        }
    }
}

__device__ __forceinline__ const void* karg(int idx) {
    const __attribute__((address_space(4))) unsigned char* ka = (const __attribute__((address_space(4))) unsigned char*)__builtin_amdgcn_kernarg_segment_ptr();
    asm volatile("" : "+s"(ka));
    return *(const void* const __attribute__((address_space(4)))*)(ka + 8 * idx);
}
#define KIN(i) ((const float*)karg(i))
#define KOUT ((float*)karg(22))
#define KWS ((unsigned char*)karg(23))
#define WS_PTRS \
    unsigned char* ws = KWS; \
    bf16_t* Y = (bf16_t*)(ws + WS_Y); float* Z = (float*)(ws + WS_Z); \
    bf16_t* R1 = (bf16_t*)(ws + WS_R1); bf16_t* R2 = (bf16_t*)(ws + WS_R2); \
    unsigned char* wl = ws + WS_W + (size_t)L * WL_SIZE; \
    const int G = ogrid(), bx = obid();

template <int L, int F>
__device__ __forceinline__ void ffn_block(const Params& p, LAS unsigned char* lds, const XcdBarrier& bar) {
    WS_PTRS
    const bf16_t* wgu = (const bf16_t*)(wl + (F ? WL_GU2 : WL_GU1));
    const bf16_t* wdn = (const bf16_t*)(wl + (F ? WL_D2 : WL_D1));
    { pg8::Gemm g{Y, wgu, TP, 5632, 1024}; pg8::StaticOrder S; S.init(TP, 5632, G, bx);
      EpiSwiglu E{R1}; pg8::gemm_phase<EpiSwiglu>(lds, g, S, E);
      sample_gemm<1>(lds, Y + (size_t)TP * 1024, 1024, wgu, 5632, R1 + (size_t)TP * DFF, DFF, nullptr, nullptr, 0.f); }
    xcd_barrier(bar);
    { pg8::Gemm g{R1, wdn, TP, 1024, DFF}; pg8::StaticOrder S; S.init(TP, 1024, G, bx);
      EpiRes E{Y, Z, 0.5f}; pg8::gemm_phase<EpiRes>(lds, g, S, E);
      sample_gemm<2>(lds, R1 + (size_t)TP * DFF, DFF, wdn, 1024, nullptr, 0, Y + (size_t)TP * 1024, Z + (size_t)TP * 1024, 0.5f); }
    xcd_barrier(bar);
    constexpr int li = F ? 3 : 0;
    ln_phase(Z, Y, KIN(8) + (L * 4 + li) * 1024, KIN(9) + (L * 4 + li) * 1024, (L == 1 && F == 1) ? KOUT : nullptr);
    xcd_barrier(bar);
}

template <int L>
__device__ __forceinline__ void mix_block(const Params& p, LAS unsigned char* lds, const XcdBarrier& bar) {
    WS_PTRS
    bf16_t* MK = (bf16_t*)(ws + WS_MK); bf16_t* VT = (bf16_t*)(ws + WS_VT);
    { pg8::Gemm g{Y, (const bf16_t*)(wl + WL_IN), TP, INC, 1024}; pg8::StaticOrder S; S.init(TP, INC, G, bx);
      EpiBf16 E{R1, INC}; pg8::gemm_phase<EpiBf16>(lds, g, S, E);
      sample_gemm<0>(lds, Y + (size_t)TP * 1024, 1024, (const bf16_t*)(wl + WL_IN), INC, R1 + (size_t)TP * INC, INC, nullptr, nullptr, 0.f); }
    xcd_barrier(bar);
    mixer_prompt(lds, L, R1, R2, KIN(13), KIN(14), KOUT);
    mixer_sample(lds, L, R1, R2, KIN(13), KIN(14), KIN(3), KIN(4), KIN(5), KOUT);
    xcd_barrier(bar);
    { pg8::Gemm g{R2, (const bf16_t*)(wl + WL_OUT), TP, 1024, 1024}; pg8::StaticOrder S; S.init(TP, 1024, G, bx);
      EpiRes E{Y, Z, 1.0f}; pg8::gemm_phase<EpiRes>(lds, g, S, E);
      sample_gemm<2>(lds, R2 + (size_t)TP * 1024, 1024, (const bf16_t*)(wl + WL_OUT), 1024, nullptr, 0, Y + (size_t)TP * 1024, Z + (size_t)TP * 1024, 1.0f); }
    xcd_barrier(bar);
    ln_phase(Z, Y, KIN(8) + (L * 4 + 1) * 1024, KIN(9) + (L * 4 + 1) * 1024, nullptr);
    xcd_barrier(bar);
    { pg8::Gemm g{Y, (const bf16_t*)(wl + WL_CQ), TP, 1024, 1024}; pg8::StaticOrder S; S.init(TP, 1024, G, bx);
      EpiBf16 E{R1, 1024}; pg8::gemm_phase<EpiBf16>(lds, g, S, E);
      sample_gemm<0>(lds, Y + (size_t)TP * 1024, 1024, (const bf16_t*)(wl + WL_CQ), 1024, R1 + (size_t)TP * 1024, 1024, nullptr, nullptr, 0.f); }
    xcd_barrier(bar);
    cross_prompt(lds, L, R1, MK, VT, R2);
    cross_sample(lds, L, R1, KIN(6), KIN(7), R2);
    xcd_barrier(bar);
    { pg8::Gemm g{R2, (const bf16_t*)(wl + WL_CO), TP, 1024, 1024}; pg8::StaticOrder S; S.init(TP, 1024, G, bx);
      EpiRes E{Y, Z, 1.0f}; pg8::gemm_phase<EpiRes>(lds, g, S, E);
      sample_gemm<2>(lds, R2 + (size_t)TP * 1024, 1024, (const bf16_t*)(wl + WL_CO), 1024, nullptr, 0, Y + (size_t)TP * 1024, Z + (size_t)TP * 1024, 1.0f); }
    xcd_barrier(bar);
    ln_phase(Z, Y, KIN(8) + (L * 4 + 2) * 1024, KIN(9) + (L * 4 + 2) * 1024, nullptr);
    xcd_barrier(bar);
}

template <int L>
__device__ __forceinline__ void prep_layer(const Params& p, LAS unsigned char* lds) {
    unsigned char* ws = KWS;
    unsigned char* wl = ws + WS_W + (size_t)L * WL_SIZE;
    bf16_t* MKVW = (bf16_t*)(ws + WS_MKVW);
    tr_job(lds, KIN(10) + (size_t)L * 1024 * 5632, 5632, 1024, (bf16_t*)(wl + WL_GU1), 5632, true);
    tr_job(lds, KIN(11) + (size_t)L * 2816 * 1024, 1024, 2816, (bf16_t*)(wl + WL_D1), 1024, false);
    tr_job(lds, KIN(12) + (size_t)L * 1024 * 2304, 2304, 1024, (bf16_t*)(wl + WL_IN), 2304, false);
    tr_job(lds, KIN(15) + (size_t)L * 1024 * 1024, 1024, 1024, (bf16_t*)(wl + WL_OUT), 1024, false);
    tr_job(lds, KIN(16) + (size_t)L * 1024 * 1024, 1024, 1024, (bf16_t*)(wl + WL_CQ), 1024, false);
    tr_job(lds, KIN(19) + (size_t)L * 1024 * 1024, 1024, 1024, (bf16_t*)(wl + WL_CO), 1024, false);
    tr_job(lds, KIN(20) + (size_t)L * 1024 * 5632, 5632, 1024, (bf16_t*)(wl + WL_GU2), 5632, true);
    tr_job(lds, KIN(21) + (size_t)L * 2816 * 1024, 1024, 2816, (bf16_t*)(wl + WL_D2), 1024, false);
    tr_job(lds, KIN(17) + (size_t)L * 1024 * 1024, 1024, 1024, MKVW + (size_t)(L * 2048) * 1024, 1024, false);
    tr_job(lds, KIN(18) + (size_t)L * 1024 * 1024, 1024, 1024, MKVW + (size_t)(L * 2048 + 1024) * 1024, 1024, false);
}

__global__ void __launch_bounds__(512) hymba_fwd(Params p) {
    extern __shared__ __attribute__((aligned(16))) unsigned char smem[];
    LAS unsigned char* lds = (LAS unsigned char*)smem;
    if (gridDim.x > 65536u) cg::this_grid().sync();
    if (threadIdx.x < 4) ((LAS unsigned*)(lds + 131072))[threadIdx.x] = 0u;
    __syncthreads();
    const XcdBarrier bar = xcd_barrier_post((unsigned*)(KWS + WS_BAR), (volatile LAS unsigned*)(lds + 131072));

    prep_layer<0>(p, lds);
    prep_layer<1>(p, lds);
    {
        unsigned char* ws = KWS;
        bf16_t* Y = (bf16_t*)(ws + WS_Y);
        cvt_job(KIN(0), Y, (size_t)TP * 1024);
        cvt_job(KIN(1), Y + (size_t)TP * 1024, (size_t)TS * 1024);
        cvt_job(KIN(2), (bf16_t*)(ws + WS_MEMB), (size_t)512 * 1024);
    }
    xcd_barrier(bar);

    {
        unsigned char* ws = KWS;
        const int G = ogrid(), bx = obid();
        pg8::Gemm g{(bf16_t*)(ws + WS_MEMB), (bf16_t*)(ws + WS_MKVW), 512, 4096, 1024}; pg8::StaticOrder S; S.init(512, 4096, G, (bx + 128) % G);
        EpiMemKV E{KOUT, (bf16_t*)(ws + WS_MK), (bf16_t*)(ws + WS_VT)};
        pg8::gemm_phase<EpiMemKV>(lds, g, S, E);
    }
    ffn_block<0, 0>(p, lds, bar);
    mix_block<0>(p, lds, bar);
    ffn_block<0, 1>(p, lds, bar);
    ffn_block<1, 0>(p, lds, bar);
    mix_block<1>(p, lds, bar);
    ffn_block<1, 1>(p, lds, bar);
}

extern "C" void kernel_launch(void* const* d_in, const int* in_sizes, int n_in, void* d_out, int out_size, void* d_ws, size_t ws_size, hipStream_t stream) {
    static int grid_blocks = 0;
    if (!grid_blocks) {
        int dev = 0, cus = 0, per_cu = 0;
        hipGetDevice(&dev);
        hipDeviceGetAttribute(&cus, hipDeviceAttributeMultiprocessorCount, dev);
        if (hipFuncSetAttribute((const void*)hymba_fwd, hipFuncAttributeMaxDynamicSharedMemorySize, LDS_BYTES) != hipSuccess) fprintf(stderr, "hipFuncSetAttribute failed\n");
        if (hipOccupancyMaxActiveBlocksPerMultiprocessor(&per_cu, (const void*)hymba_fwd, 512, LDS_BYTES) != hipSuccess || per_cu < 1) { fprintf(stderr, "occupancy query: %d\n", per_cu); per_cu = 1; }
        (void)hipGetLastError();
        grid_blocks = cus > 0 ? cus : 256;
        if (ws_size < WS_END) fprintf(stderr, "workspace too small: %zu < %zu\n", ws_size, (size_t)WS_END);
    }
    if (hipMemsetAsync((char*)d_ws + WS_BAR, 0, 65536, stream) != hipSuccess) fprintf(stderr, "memset failed\n");
    Params p{};
    for (int i = 0; i < 22; ++i) p.in[i] = (const float*)d_in[i];
    p.out = (float*)d_out; p.ws = (unsigned char*)d_ws;
    void* args[] = {&p};
    hipError_t e = hipLaunchCooperativeKernel((const void*)hymba_fwd, dim3(grid_blocks), dim3(512), args, LDS_BYTES, stream);
    if (e != hipSuccess) fprintf(stderr, "cooperative launch failed: %s (grid %d)\n", hipGetErrorString(e), grid_blocks);
}
```
